# Optimizing an MI355X kernel written in HIP

```python
import jax, jax.numpy as jnp
from jax import lax
import numpy as np

D_MODEL = 1024
BATCH = 8
SEQ = 2048
DEPTH = 1
DEC_BATCH = 4
DEC_SEQ = 8192
PAST_LEN = 128

N_META = 16
GRID_W = 64
EXPAND = 2
D_MIX = EXPAND * D_MODEL
D_POOL = D_MIX // 2
D_NA = D_MIX - D_POOL
POOL_WINDOWS = (2, 4, 8, 16)
N_POOL_GROUPS = len(POOL_WINDOWS)
POOL_GROUP_W = D_POOL // N_POOL_GROUPS
NA_HEAD_DIM = 64
NA_HEADS = D_NA // NA_HEAD_DIM
NA_KR_MAX = 8
NA_KC = 16
RMS_EPS = 1e-6
D_IN = 2 * D_POOL + 4 * D_NA

kernel_name = "hymba_pool_natten_encoder"


def rms_norm(x, g):
    xf = x.astype(jnp.float32)
    y = xf * lax.rsqrt(jnp.mean(xf * xf, axis=-1, keepdims=True) + RMS_EPS)
    return (y * g.astype(jnp.float32)).astype(x.dtype)


def pool_mixer(u, w_pool, pool_scale):
    B, L, _ = u.shape
    ug = u.reshape(B, L, N_POOL_GROUPS, POOL_GROUP_W)
    ugf = ug.astype(jnp.float32)
    cs = jnp.concatenate([jnp.zeros((B, 1, N_POOL_GROUPS, POOL_GROUP_W), jnp.float32),
                          jnp.cumsum(ugf, axis=1)], axis=1)
    w = jnp.array(POOL_WINDOWS, jnp.int32)
    t = jnp.arange(L, dtype=jnp.int32)
    start = t[:, None] - w[None, :] // 2
    lo = jnp.clip(start, 0, L)
    hi = jnp.clip(start + w[None, :], 0, L)
    gidx = jnp.arange(N_POOL_GROUPS)[None, :]
    win_sum = cs[:, hi, gidx, :] - cs[:, lo, gidx, :]
    count = (hi - lo).astype(jnp.float32)[None, :, :, None]
    pooled = (win_sum / count - ugf).astype(u.dtype)
    mixed = jnp.einsum('blgc,gcd->blgd', pooled, w_pool).reshape(B, L, D_POOL)
    return mixed * pool_scale


def neighborhood_attention(q, k, v, rpb, meta_bias):
    B, L, H, hd = q.shape
    T = L - N_META
    rows = T // GRID_W
    kr_n = min(NA_KR_MAX, rows)
    scale = hd ** -0.5
    qm, km, vm = q[:, :N_META], k[:, :N_META], v[:, :N_META]
    qg = q[:, N_META:].reshape(B, rows, GRID_W, H, hd)
    kg = k[:, N_META:].reshape(B, rows, GRID_W, H, hd)
    vg = v[:, N_META:].reshape(B, rows, GRID_W, H, hd)
    cols = np.arange(GRID_W)
    cstart = np.clip(cols - NA_KC // 2, 0, GRID_W - NA_KC)
    colidx = cstart[:, None] + np.arange(NA_KC)[None, :]
    coloff = colidx - cols[:, None] + (NA_KC - 1)
    mbias = meta_bias.astype(jnp.float32)[None, :, None, :]

    def row_block(r):
        rs = jnp.clip(r - kr_n // 2, 0, rows - kr_n)
        q_r = lax.dynamic_index_in_dim(qg, r, axis=1, keepdims=False)
        k_r = lax.dynamic_slice_in_dim(kg, rs, kr_n, axis=1)[:, :, colidx]
        v_r = lax.dynamic_slice_in_dim(vg, rs, kr_n, axis=1)[:, :, colidx]
        rowoff = rs + jnp.arange(kr_n) - r + (NA_KR_MAX - 1)
        bias = rpb[:, rowoff][:, :, coloff]
        bias = bias.transpose(0, 2, 1, 3).astype(jnp.float32)[None]
        s_grid = jnp.einsum('bqhd,bkqjhd->bhqkj', q_r, k_r).astype(jnp.float32) * scale + bias
        s_grid = s_grid.reshape(B, H, GRID_W, kr_n * NA_KC)
        s_meta = jnp.einsum('bqhd,bmhd->bhqm', q_r, km).astype(jnp.float32) * scale + mbias
        p = jax.nn.softmax(jnp.concatenate([s_meta, s_grid], axis=-1), axis=-1).astype(v.dtype)
        p_m = p[..., :N_META]
        p_g = p[..., N_META:].reshape(B, H, GRID_W, kr_n, NA_KC)
        return (jnp.einsum('bhqm,bmhd->bqhd', p_m, vm)
                + jnp.einsum('bhqkj,bkqjhd->bqhd', p_g, v_r))

    out_g = lax.map(row_block, jnp.arange(rows))
    out_g = out_g.transpose(1, 0, 2, 3, 4).reshape(B, T, H, hd)
    s_mm = jnp.einsum('bqhd,bmhd->bhqm', qm, km).astype(jnp.float32) * scale + mbias
    p_mm = jax.nn.softmax(s_mm, axis=-1).astype(v.dtype)
    out_m = jnp.einsum('bhqm,bmhd->bqhd', p_mm, vm)
    return jnp.concatenate([out_m, out_g], axis=1).reshape(B, L, H * hd)


def mixer_layer(x, norm_g, w_in, w_pool, pool_scale, rpb, meta_bias, w_out):
    B, L, _ = x.shape
    h = rms_norm(x, norm_g)
    proj = h @ w_in
    splits = [D_POOL, 2 * D_POOL, 2 * D_POOL + D_NA, 2 * D_POOL + 2 * D_NA, 2 * D_POOL + 3 * D_NA]
    u, g_pool, q, k, v, g_na = jnp.split(proj, splits, axis=-1)
    pool_out = pool_mixer(u, w_pool, pool_scale) * jax.nn.silu(g_pool)
    shp = (B, L, NA_HEADS, NA_HEAD_DIM)
    na_out = neighborhood_attention(q.reshape(shp), k.reshape(shp), v.reshape(shp),
                                    rpb, meta_bias) * jax.nn.silu(g_na)
    return x + jnp.concatenate([pool_out, na_out], axis=-1) @ w_out


def encode(x, meta_tokens, norm_g, w_in, w_pool, pool_scale, rpb, meta_bias, w_out, final_g):
    B = x.shape[0]
    meta = jnp.broadcast_to(meta_tokens[None].astype(x.dtype), (B, N_META, x.shape[-1]))
    h = jnp.concatenate([meta, x], axis=1)
    for l in range(DEPTH):
        h = mixer_layer(h, norm_g[l], w_in[l], w_pool[l], pool_scale[l], rpb[l],
                        meta_bias[l], w_out[l])
    return rms_norm(h, final_g)[:, N_META:]


def setup_inputs(seed: int = 0) -> dict:
    key = jax.random.key(seed)
    ks = jax.random.split(key, 12)
    f32 = jnp.float32
    return {
        "x_prompt": jax.random.normal(ks[0], (BATCH, SEQ, D_MODEL), f32),
        "x_sample": jax.random.normal(ks[1], (DEC_BATCH, DEC_SEQ, D_MODEL), f32),
        "meta_tokens": jax.random.normal(ks[2], (N_META, D_MODEL), f32),
        "norm_g": 1.0 + 0.02 * jax.random.normal(ks[3], (DEPTH, D_MODEL), f32),
        "w_in": jax.random.normal(ks[4], (DEPTH, D_MODEL, D_IN), f32) * D_MODEL ** -0.5,
        "w_pool": jax.random.normal(ks[5], (DEPTH, N_POOL_GROUPS, POOL_GROUP_W, POOL_GROUP_W), f32) * POOL_GROUP_W ** -0.5,
        "pool_scale": 1.0 + 0.02 * jax.random.normal(ks[6], (DEPTH, D_POOL), f32),
        "rpb": 0.02 * jax.random.normal(ks[7], (DEPTH, NA_HEADS, 2 * NA_KR_MAX - 1, 2 * NA_KC - 1), f32),
        "meta_bias": 0.02 * jax.random.normal(ks[8], (DEPTH, NA_HEADS, N_META), f32),
        "w_out": jax.random.normal(ks[9], (DEPTH, D_MIX, D_MODEL), f32) * D_MIX ** -0.5,
        "final_g": 1.0 + 0.02 * jax.random.normal(ks[10], (D_MODEL,), f32),
    }


def reference(x_prompt, x_sample, meta_tokens, norm_g, w_in, w_pool, pool_scale, rpb,
              meta_bias, w_out, final_g):
    y_prompt = encode(x_prompt, meta_tokens, norm_g, w_in, w_pool, pool_scale, rpb,
                      meta_bias, w_out, final_g)
    y_sample = encode(x_sample, meta_tokens, norm_g, w_in, w_pool, pool_scale, rpb,
                      meta_bias, w_out, final_g)
    return (y_prompt, y_sample)
```

```cpp
#include <hip/hip_runtime.h>
#include <hip/hip_cooperative_groups.h>
#include <cstdio>
#include <cstdint>
namespace cg = cooperative_groups;

#ifndef MK_N_LAUNCHES
#define MK_N_LAUNCHES 1
#endif
#ifndef FUSE_NORM
#define FUSE_NORM 1
#endif

#define LAS __attribute__((address_space(3)))
typedef unsigned short bf16_t;
typedef short bf16x8 __attribute__((ext_vector_type(8)));
typedef float f32x4 __attribute__((ext_vector_type(4)));
typedef float f32x2 __attribute__((ext_vector_type(2)));
typedef unsigned u32x4 __attribute__((ext_vector_type(4)));
typedef unsigned u32x2 __attribute__((ext_vector_type(2)));

constexpr int DM = 1024;
constexpr int MR = 49152;
constexpr int MP = 16384;
constexpr int NPROJ = 6144;
constexpr int LDP5 = 5120;
constexpr int NMETA = 16;
constexpr float RMS_EPS = 1e-6f;

constexpr size_t MiB = 1u << 20;
constexpr size_t WS_W1T = 0;
constexpr size_t WS_W2T = 12 * MiB;
constexpr size_t WS_HM = 16 * MiB;
constexpr size_t WS_UM = 16 * MiB + 32768;
constexpr size_t WS_PROJM = 16 * MiB + 65536;
constexpr size_t WS_SSQ = 17 * MiB;
constexpr size_t WS_CNT = 19 * MiB;
constexpr size_t WS_BAR = 19 * MiB + 65536;
constexpr size_t WS_P5 = 20 * MiB;
constexpr size_t WS_END = WS_P5 + (size_t)MR * LDP5 * 2;
constexpr size_t OUT_U = 0, OUT_HB = (size_t)MR * 1024 * 2;

constexpr int LDS_BYTES = 160 * 1024;

__device__ __forceinline__ unsigned f2bf(float f) { unsigned u = __builtin_bit_cast(unsigned, f); return (u + 0x7fffu + ((u >> 16) & 1u)) >> 16; }
typedef __bf16 bf16x2_t __attribute__((ext_vector_type(2)));
__device__ __forceinline__ unsigned pk2(float lo, float hi) { const f32x2 v = {lo, hi}; return __builtin_bit_cast(unsigned, __builtin_convertvector(v, bf16x2_t)); }
__device__ __forceinline__ float bflo(unsigned w) { return __builtin_bit_cast(float, w << 16); }
__device__ __forceinline__ float bfhi(unsigned w) { return __builtin_bit_cast(float, w & 0xffff0000u); }
__device__ __forceinline__ float wave_sum(float v) {
#pragma unroll
    for (int o = 1; o < 64; o <<= 1) v += __shfl_xor(v, o);
    return v;
}
#define LDS_WAIT() asm volatile("s_waitcnt lgkmcnt(0)" ::: "memory")

namespace pg8 {
constexpr int BM = 256, BK = 64, HALF = 128, HTB = HALF * BK * 2, STAGE_BYTES = 8 * HTB, NXCD = 8, WGM = 8;
__host__ __device__ __forceinline__ int lds_byte(int r, int c) { const int st = (r >> 4) * 2 + (c >> 5), rr = r & 15, cc = c & 31, ob = rr * 64 + cc * 2; return st * 1024 + (ob ^ (((ob >> 9) & 1) << 5)); }
__host__ __device__ __forceinline__ void stage_rc(int b, int& R, int& C) { const int st = b / 1024, sb = b % 1024, swz = sb ^ (((sb >> 9) & 1) << 5); R = (st >> 1) * 16 + swz / 64; C = (st & 1) * 32 + (swz % 64) / 2; }
__host__ __device__ __forceinline__ int perm32(int rho) { const int n = rho >> 4, i = rho & 15; return 8 * (i >> 2) + 4 * n + (i & 3); }

struct Unit { int pm, pn; };
struct Gemm { const bf16_t* A; const bf16_t* Bt; int M, N, K, lda; };

struct StaticOrder {
    int nM, nN, nwg, G, c;
    __host__ __device__ void init(int M, int N, int G_, int c_) { nM = M / BM; nN = N / BM; nwg = nM * nN; G = G_; c = c_; }
    __host__ __device__ bool next(int i, Unit& u) const {
        const long L = (long)i * G + c; if (L >= nwg) return false;
        int wgid = (int)L; { const int q = nwg / NXCD, r = nwg % NXCD, xcd = wgid % NXCD, off = wgid / NXCD; wgid = (xcd < r ? xcd * (q + 1) : r * (q + 1) + (xcd - r) * q) + off; }
        const int nig = WGM * nN, gid = wgid / nig, fm = gid * WGM, gsz = (nM - fm) < WGM ? (nM - fm) : WGM;
        u.pm = fm + ((wgid % nig) % gsz); u.pn = (wgid % nig) / gsz; return true;
    }
};

__device__ __forceinline__ unsigned cvt_pk_bf16(float lo, float hi) { const f32x2 v = {lo, hi}; return __builtin_bit_cast(unsigned, __builtin_convertvector(v, bf16x2_t)); }

struct EpiProj {
    static constexpr bool PERM = true;
    bf16_t* U; bf16_t* P5;
    __device__ __forceinline__ void operator()(const f32x4 (&acc)[2][2][4][2], const Unit& u, int wr, int wc, int fr, int fq) const {
        const int row0 = u.pm * BM + wr * 64 + fr;
        bf16_t* base; int ldc, colt;
        if (u.pn < 4) { base = U; ldc = 1024; colt = u.pn * BM; } else { base = P5; ldc = LDP5; colt = u.pn * BM - 1024; }
        const int col0 = colt + wc * 32 + 8 * fq;
#pragma unroll
        for (int ai = 0; ai < 2; ++ai)
#pragma unroll
            for (int m = 0; m < 4; ++m) { bf16_t* rowp = base + (size_t)(row0 + ai * HALF + m * 16) * ldc + col0;
#pragma unroll
                for (int bj = 0; bj < 2; ++bj) { const f32x4 v0 = acc[ai][bj][m][0], v1 = acc[ai][bj][m][1];
                    u32x4 w; w.x = cvt_pk_bf16(v0[0], v0[1]); w.y = cvt_pk_bf16(v0[2], v0[3]); w.z = cvt_pk_bf16(v1[0], v1[1]); w.w = cvt_pk_bf16(v1[2], v1[3]);
                    *(u32x4*)(rowp + bj * HALF) = w; } }
    }
};
struct EpiOut {
    static constexpr bool PERM = false;
    const float* xp; const float* xs; float* out; float* ssq;
    __device__ __forceinline__ void operator()(const f32x4 (&acc)[2][2][4][2], const Unit& u, int wr, int wc, int fr, int fq) const {
        const int row0 = u.pm * BM + wr * 64 + fr, col0 = u.pn * BM + wc * 32 + 4 * fq;
#pragma unroll
        for (int ai = 0; ai < 2; ++ai)
#pragma unroll
            for (int m = 0; m < 4; ++m) { const int r = row0 + ai * HALF + m * 16;
                const float* xr = (r < MP) ? xp + (size_t)r * DM : xs + (size_t)(r - MP) * DM; float* orow = out + (size_t)r * DM; float s = 0.f;
#pragma unroll
                for (int bj = 0; bj < 2; ++bj)
#pragma unroll
                    for (int n = 0; n < 2; ++n) { const int c = col0 + bj * HALF + n * 16; const f32x4 v = acc[ai][bj][m][n] + *(const f32x4*)(xr + c);
                        *(f32x4*)(orow + c) = v; s += (v[0] * v[0] + v[1] * v[1]) + (v[2] * v[2] + v[3] * v[3]); }
                s += __shfl_xor(s, 16); s += __shfl_xor(s, 32);
                if (fq == 0) ssq[(size_t)r * 16 + u.pn * 4 + wc] = s;
                if (m & 1) asm volatile("" ::: "memory"); }
    }
};

struct PanelOrder {
    int nwg, G, c;
    __host__ __device__ void init(int M, int N, int G_, int bx) { nwg = (M / BM) * (N / BM); G = G_; c = (G_ % 8 == 0) ? (bx % 8) * (G_ / 8) + bx / 8 : bx; }
    __host__ __device__ bool next(int i, Unit& u) const { const long L = (long)i * G + c; if (L >= nwg) return false; u.pm = (int)(L >> 2); u.pn = (int)(L & 3); return true; }
};
struct EpiOutN {
    static constexpr bool PERM = false;
    const float* xp; const float* xs; float* out; float* xch; unsigned* cnt; const float* fg; LAS unsigned char* lx;
    __device__ __forceinline__ void operator()(f32x4 (&acc)[2][2][4][2], const Unit& u, int wr, int wc, int fr, int fq) const {
        const int tid = threadIdx.x, lane = tid & 63, wid = tid >> 6;
        LAS float* part = (LAS float*)lx;
        LAS float* rst = (LAS float*)(lx + 4096);
        const int row0 = u.pm * BM + wr * 64 + fr, col0 = u.pn * BM + wc * 32 + 4 * fq;
#pragma unroll
        for (int ai = 0; ai < 2; ++ai)
#pragma unroll
            for (int m = 0; m < 4; ++m) { const int r = row0 + ai * HALF + m * 16;
                const float* xr = (r < MP) ? xp + (size_t)r * DM : xs + (size_t)(r - MP) * DM; float s = 0.f;
#pragma unroll
                for (int bj = 0; bj < 2; ++bj)
#pragma unroll
                    for (int n = 0; n < 2; ++n) { const int c = col0 + bj * HALF + n * 16; const f32x4 v = acc[ai][bj][m][n] + __builtin_nontemporal_load((const f32x4*)(xr + c));
                        acc[ai][bj][m][n] = v; s += (v[0] * v[0] + v[1] * v[1]) + (v[2] * v[2] + v[3] * v[3]); }
                s += __shfl_xor(s, 16); s += __shfl_xor(s, 32);
                if (fq == 0) part[(ai * HALF + wr * 64 + m * 16 + fr) * 4 + wc] = s;
                if (m & 1) asm volatile("" ::: "memory"); }
        asm volatile("s_waitcnt lgkmcnt(0)" ::: "memory"); __builtin_amdgcn_s_barrier(); asm volatile("" ::: "memory");
        const int row = wid * 32 + (lane & 31);
        if (lane < 32) { const f32x4 pp = *(const LAS f32x4*)(part + row * 4);
            __hip_atomic_store(xch + (size_t)(u.pm * BM + row) * 4 + u.pn, (pp.x + pp.y) + (pp.z + pp.w), __ATOMIC_RELAXED, __HIP_MEMORY_SCOPE_AGENT); }
        asm volatile("s_waitcnt vmcnt(0)" ::: "memory");
        if (lane == 0) __hip_atomic_fetch_add(cnt + 64 * u.pm, 1u, __ATOMIC_RELAXED, __HIP_MEMORY_SCOPE_AGENT);
        if (wid == 0) {
            unsigned sp = 0;
            while ((unsigned)__builtin_amdgcn_readfirstlane(__hip_atomic_load(cnt + 64 * u.pm, __ATOMIC_RELAXED, __HIP_MEMORY_SCOPE_AGENT)) < 32u) { __builtin_amdgcn_s_sleep(2); if (++sp > (1u << 22)) break; }
            __builtin_amdgcn_fence(__ATOMIC_ACQUIRE, "agent");
        }
        asm volatile("s_waitcnt vmcnt(0) lgkmcnt(0)" ::: "memory"); __builtin_amdgcn_s_barrier(); asm volatile("" ::: "memory");
        if (lane < 32) { const float* sl = xch + (size_t)(u.pm * BM + row) * 4; float t = 0.f;
#pragma unroll
            for (int k = 0; k < 4; ++k) t += __hip_atomic_load(sl + k, __ATOMIC_RELAXED, __HIP_MEMORY_SCOPE_AGENT);
            rst[row] = 1.0f / sqrtf(t * (1.f / DM) + RMS_EPS); }
        asm volatile("s_waitcnt vmcnt(0) lgkmcnt(0)" ::: "memory"); __builtin_amdgcn_s_barrier(); asm volatile("" ::: "memory");
        f32x4 g4[2][2];
#pragma unroll
        for (int bj = 0; bj < 2; ++bj)
#pragma unroll
            for (int n = 0; n < 2; ++n) g4[bj][n] = *(const f32x4*)(fg + col0 + bj * HALF + n * 16);
#pragma unroll
        for (int ai = 0; ai < 2; ++ai)
#pragma unroll
            for (int m = 0; m < 4; ++m) { const int rl = ai * HALF + wr * 64 + m * 16 + fr; const float rs_ = rst[rl]; float* orow = out + (size_t)(u.pm * BM + rl) * DM;
#pragma unroll
                for (int bj = 0; bj < 2; ++bj)
#pragma unroll
                    for (int n = 0; n < 2; ++n) *(f32x4*)(orow + col0 + bj * HALF + n * 16) = acc[ai][bj][m][n] * rs_ * g4[bj][n]; }
        asm volatile("s_waitcnt lgkmcnt(0)" ::: "memory"); __builtin_amdgcn_s_barrier(); asm volatile("" ::: "memory");
    }
};

template <class Epi, class Sched, bool ALIGN_EPI>
__device__ __forceinline__ void gemm_phase(LAS unsigned char* lds, const Gemm g, const Sched& S, const Epi& E) {
    const int tid = threadIdx.x, wid = __builtin_amdgcn_readfirstlane(tid >> 6), lane = tid & 63, wr = wid >> 2, wc = wid & 3, fr = lane & 15, fq = lane >> 4;
    const int K = g.K, nt = K / BK, lda = g.lda;
    unsigned voffA[2], voffB[2];
#pragma unroll
    for (int i = 0; i < 2; ++i) { int R, C; stage_rc(tid * 16 + i * 8192, R, C); const int Rb = Epi::PERM ? ((R & ~31) + perm32(R & 31)) : R;
        voffA[i] = (unsigned)(R * lda + C) * 2u; voffB[i] = (unsigned)(Rb * K + C) * 2u; }
    const size_t kstep = (size_t)(BK * 2);
    const size_t hA = (size_t)HALF * lda * 2, hB = (size_t)HALF * K * 2;
    const size_t tA = 2 * hA, tB = 2 * hB;
    const unsigned ldsw = (unsigned)wid * 1024u;
    const int aoff = lds_byte(wr * 64 + fr, fq * 8), boff = lds_byte(wc * 32 + fr, fq * 8);
#define PG8_SA(b, h) (((b) * 2 + (h)) * HTB)
#define PG8_SB(b, h) ((4 + (b) * 2 + (h)) * HTB)
#define PG8_STAGE(bufoff, gbase, voff) do { _Pragma("unroll") for (int _i = 0; _i < 2; ++_i) \
        __builtin_amdgcn_global_load_lds((const unsigned*)((const char*)(gbase) + (voff)[_i]), (LAS unsigned*)(lds + (bufoff) + ldsw + _i * 8192), 16, 0, 0); } while (0)
#define PG8_LDA(dst, b, h) do { _Pragma("unroll") for (int m = 0; m < 4; ++m) _Pragma("unroll") for (int k = 0; k < 2; ++k) dst[m][k] = *(const LAS bf16x8*)(lds + PG8_SA(b, h) + aoff + m * 2048 + k * 1024); } while (0)
#define PG8_LDB(dst, b, h) do { _Pragma("unroll") for (int n = 0; n < 2; ++n) _Pragma("unroll") for (int k = 0; k < 2; ++k) dst[n][k] = *(const LAS bf16x8*)(lds + PG8_SB(b, h) + boff + n * 2048 + k * 1024); } while (0)
#define PG8_MMA(ai, bj, At, Bt) do { __builtin_amdgcn_s_setprio(1); _Pragma("unroll") for (int m = 0; m < 4; ++m) _Pragma("unroll") for (int n = 0; n < 2; ++n) _Pragma("unroll") for (int k = 0; k < 2; ++k) \
        acc[ai][bj][m][n] = __builtin_amdgcn_mfma_f32_16x16x32_bf16(Bt[n][k], At[m][k], acc[ai][bj][m][n], 0, 0, 0); __builtin_amdgcn_s_setprio(0); } while (0)
#define PG8_WAIT_V(n) asm volatile("s_waitcnt vmcnt(" #n ")" ::: "memory")
#define PG8_WAIT_L(n) asm volatile("s_waitcnt lgkmcnt(" #n ")" ::: "memory")
#define PG8_BAR __builtin_amdgcn_s_barrier()
#define PG8_SCHED __builtin_amdgcn_sched_barrier(0)
    Unit cur, nxt; int ui = 0;
    if (!S.next(0, cur)) return;
    f32x4 acc[2][2][4][2];
#pragma unroll
    for (int a = 0; a < 2; ++a)
#pragma unroll
        for (int b = 0; b < 2; ++b)
#pragma unroll
            for (int m = 0; m < 4; ++m)
#pragma unroll
                for (int n = 0; n < 2; ++n) acc[a][b][m][n] = (f32x4){0.f, 0.f, 0.f, 0.f};
    bf16x8 At[4][2], B0[2][2], B1[2][2];
    const char* cA = (const char*)g.A + (size_t)cur.pm * tA; const char* cB = (const char*)g.Bt + (size_t)cur.pn * tB;
    PG8_STAGE(PG8_SB(0, 0), cB, voffB); PG8_STAGE(PG8_SB(0, 1), cB + hB, voffB); PG8_STAGE(PG8_SA(0, 0), cA, voffA); PG8_STAGE(PG8_SA(0, 1), cA + hA, voffA);
    if (wr == 1) PG8_BAR;
    PG8_WAIT_V(2); PG8_BAR;
    PG8_STAGE(PG8_SB(1, 0), cB + kstep, voffB); PG8_STAGE(PG8_SA(1, 0), cA + kstep, voffA); PG8_STAGE(PG8_SB(1, 1), cB + hB + kstep, voffB);
    PG8_WAIT_V(6); PG8_BAR;
    for (;;) {
        const bool has_next = S.next(ui + 1, nxt);
        const char* nA = has_next ? (const char*)g.A + (size_t)nxt.pm * tA : cA; const char* nB = has_next ? (const char*)g.Bt + (size_t)nxt.pn * tB : cB;
        for (int t = 0; t < nt; t += 2) {
            const bool last = (t == nt - 2);
            const char* a1 = cA + (size_t)(t + 1) * kstep;
            const char* a2 = last ? nA : cA + (size_t)(t + 2) * kstep; const char* b2 = last ? nB : cB + (size_t)(t + 2) * kstep;
            const char* a3 = a2 + kstep; const char* b3 = b2 + kstep;
            PG8_LDB(B0, 0, 0); PG8_LDB(B1, 0, 1); PG8_SCHED; PG8_LDA(At, 0, 0); PG8_STAGE(PG8_SA(1, 1), a1 + hA, voffA);
            PG8_WAIT_V(8); PG8_WAIT_L(0); PG8_BAR; PG8_MMA(0, 0, At, B0); PG8_MMA(0, 1, At, B1); PG8_BAR; PG8_SCHED;
            PG8_LDA(At, 0, 1); PG8_STAGE(PG8_SB(0, 0), b2, voffB); PG8_STAGE(PG8_SB(0, 1), b2 + hB, voffB); PG8_STAGE(PG8_SA(0, 0), a2, voffA);
            PG8_WAIT_V(8); PG8_WAIT_L(0); PG8_BAR; PG8_MMA(1, 0, At, B0); PG8_MMA(1, 1, At, B1); PG8_BAR; PG8_SCHED;
            PG8_LDB(B0, 1, 0); PG8_LDB(B1, 1, 1); PG8_SCHED; PG8_LDA(At, 1, 0); PG8_STAGE(PG8_SA(0, 1), a2 + hA, voffA);
            PG8_WAIT_V(8); PG8_WAIT_L(0); PG8_BAR; PG8_MMA(0, 0, At, B0); PG8_MMA(0, 1, At, B1); PG8_BAR; PG8_SCHED;
            PG8_LDA(At, 1, 1); PG8_STAGE(PG8_SB(1, 0), b3, voffB); PG8_STAGE(PG8_SB(1, 1), b3 + hB, voffB); PG8_STAGE(PG8_SA(1, 0), a3, voffA);
            PG8_WAIT_V(8); PG8_WAIT_L(0); PG8_BAR; PG8_MMA(1, 0, At, B0); PG8_MMA(1, 1, At, B1); PG8_BAR; PG8_SCHED;
        }
        if constexpr (ALIGN_EPI) { if (wr == 0) PG8_BAR; }
        E(acc, cur, wr, wc, fr, fq);
        if (!has_next) break;
#pragma unroll
        for (int a = 0; a < 2; ++a)
#pragma unroll
            for (int b = 0; b < 2; ++b)
#pragma unroll
                for (int m = 0; m < 4; ++m)
#pragma unroll
                    for (int n = 0; n < 2; ++n) acc[a][b][m][n] = (f32x4){0.f, 0.f, 0.f, 0.f};
        cur = nxt; cA = nA; cB = nB; ++ui;
        if constexpr (ALIGN_EPI) { if (wr == 1) PG8_BAR; }
    }
    PG8_WAIT_V(0);
    if constexpr (!ALIGN_EPI) { if (wr == 0) PG8_BAR; }
    PG8_BAR;
#undef PG8_SA
#undef PG8_SB
#undef PG8_STAGE
#undef PG8_LDA
#undef PG8_LDB
#undef PG8_MMA
#undef PG8_WAIT_V
#undef PG8_WAIT_L
#undef PG8_BAR
#undef PG8_SCHED
}
}

struct Params {
    const float *xp, *xs, *meta, *norm_g, *w_in, *w_pool, *pool_scale, *rpb, *meta_bias, *w_out, *final_g;
    float* out; unsigned char* ws; int ph_lo, ph_hi;
};

__device__ __forceinline__ void p0_transpose_item(const float* W, int ldw, int K, bf16_t* WT, LAS float* scr, int k0, int n0, int lane, float sc) {
#pragma unroll 8
    for (int i = 0; i < 32; ++i) { const int kk = 2 * i + (lane >> 5); scr[kk * 33 + (lane & 31)] = W[(size_t)(k0 + kk) * ldw + n0 + (lane & 31)] * sc; }
    LDS_WAIT();
    const int c = lane & 7;
#pragma unroll
    for (int j = 0; j < 4; ++j) { const int n = (lane >> 3) + 8 * j; const LAS float* s = scr + (8 * c) * 33 + n;
        u32x4 o; o.x = pk2(s[0 * 33], s[1 * 33]); o.y = pk2(s[2 * 33], s[3 * 33]); o.z = pk2(s[4 * 33], s[5 * 33]); o.w = pk2(s[6 * 33], s[7 * 33]);
        *(u32x4*)(WT + (size_t)(n0 + n) * K + k0 + 8 * c) = o; }
    LDS_WAIT();
}

__device__ __forceinline__ void p0_fold_item(const Params& p, bf16_t* W1T, LAS float* scr, int item, int lane) {
    LAS float* As = scr;
    LAS float* Bs = scr + 32 * 33;
    const int kb = item & 31, db = (item >> 5) & 15, g = item >> 9, k0 = kb * 32, d0 = db * 16;
    const int k2 = lane >> 2, dq = lane & 3;
    f32x4 a0 = {0.f, 0.f, 0.f, 0.f}, a1 = {0.f, 0.f, 0.f, 0.f};
    float av[16], bv[8];
#pragma unroll
    for (int i = 0; i < 16; ++i) av[i] = p.w_in[(size_t)(k0 + 2 * i + (lane >> 5)) * NPROJ + 256 * g + (lane & 31)];
#pragma unroll
    for (int i = 0; i < 8; ++i) bv[i] = p.w_pool[(size_t)(g * 256 + 4 * i + (lane >> 4)) * 256 + d0 + (lane & 15)];
    for (int cc = 0; cc < 8; ++cc) {
#pragma unroll
        for (int i = 0; i < 16; ++i) As[(2 * i + (lane >> 5)) * 33 + (lane & 31)] = av[i];
#pragma unroll
        for (int i = 0; i < 8; ++i) Bs[(4 * i + (lane >> 4)) * 16 + (lane & 15)] = bv[i];
        if (cc < 7) {
#pragma unroll
            for (int i = 0; i < 16; ++i) av[i] = p.w_in[(size_t)(k0 + 2 * i + (lane >> 5)) * NPROJ + 256 * g + (cc + 1) * 32 + (lane & 31)];
#pragma unroll
            for (int i = 0; i < 8; ++i) bv[i] = p.w_pool[(size_t)(g * 256 + (cc + 1) * 32 + 4 * i + (lane >> 4)) * 256 + d0 + (lane & 15)];
        }
        LDS_WAIT();
#pragma unroll 8
        for (int c = 0; c < 32; ++c) { const float x0 = As[(2 * k2) * 33 + c], x1 = As[(2 * k2 + 1) * 33 + c]; const f32x4 bb = *(const LAS f32x4*)(Bs + c * 16 + 4 * dq);
            a0 += x0 * bb; a1 += x1 * bb; }
        LDS_WAIT();
    }
#pragma unroll
    for (int j = 0; j < 4; ++j) *(unsigned*)(W1T + (size_t)(256 * g + d0 + 4 * dq + j) * 1024 + k0 + 2 * k2) = pk2(a0[j], a1[j]);
}
__device__ __forceinline__ void p0_norm_row(const Params& p, bf16_t* HB, bf16_t* HM, int row, int lane) {
    const float* src = row < MP ? p.xp + (size_t)row * DM : (row < MR ? p.xs + (size_t)(row - MP) * DM : p.meta + (size_t)(row - MR) * DM);
    bf16_t* dst = row < MR ? HB + (size_t)row * DM : HM + (size_t)(row - MR) * DM;
    const f32x4* xr = (const f32x4*)src + lane; const f32x4* g4 = (const f32x4*)p.norm_g + lane;
    f32x4 v[4]; float s = 0.f;
#pragma unroll
    for (int j = 0; j < 4; ++j) { v[j] = __builtin_nontemporal_load(xr + 64 * j); s += (v[j].x * v[j].x + v[j].y * v[j].y) + (v[j].z * v[j].z + v[j].w * v[j].w); }
    const float rstd = 1.0f / sqrtf(wave_sum(s) * (1.f / DM) + RMS_EPS);
    u32x2* o8 = (u32x2*)dst + lane;
#pragma unroll
    for (int j = 0; j < 4; ++j) { const f32x4 gg = g4[64 * j]; u32x2 w; w.x = pk2(v[j].x * rstd * gg.x, v[j].y * rstd * gg.y); w.y = pk2(v[j].z * rstd * gg.z, v[j].w * rstd * gg.w); __builtin_nontemporal_store(w, o8 + 64 * j); }
}
__device__ __forceinline__ void p0_prologue(const Params& p, LAS unsigned char* lds, int tid, int lane, int wave) {
    bf16_t* W1T = (bf16_t*)(p.ws + WS_W1T); bf16_t* W2T = (bf16_t*)(p.ws + WS_W2T);
    bf16_t* HM = (bf16_t*)(p.ws + WS_HM); bf16_t* HB = (bf16_t*)((unsigned char*)p.out + OUT_HB);
    const int G = gridDim.x;
    LAS float* scr = (LAS float*)(lds + wave * 16384);
    const int gw = blockIdx.x * 8 + wave, NGW = G * 8;
    constexpr int IF = 2048, I1 = 16 * 160, I2 = 32 * 32;
    const int nrows = MR + NMETA, half = ((nrows / NGW) / 2) * NGW;
    if (wave & 1) for (int row = gw; row < half; row += NGW) p0_norm_row(p, HB, HM, row, lane);
    for (int it = gw; it < IF; it += NGW) p0_fold_item(p, W1T, scr, it, lane);
    for (int it = gw; it < I1 + I2; it += NGW) {
        if (it < I1) { const int kb = it / 160, nb = it % 160; const int nn = 1024 + nb * 32; p0_transpose_item(p.w_in, NPROJ, 1024, W1T, scr, kb * 64, nn, lane, (nn >= 2048 && nn < 3072) ? 0.125f * 1.4426950408889634f : 1.0f); }
        else { const int r = it - I1; const int kb = r / 32, nb = r % 32; p0_transpose_item(p.w_out, 1024, 2048, W2T, scr, kb * 64, nb * 32, lane, 1.0f); }
    }
    if (!(wave & 1)) for (int row = gw; row < half; row += NGW) p0_norm_row(p, HB, HM, row, lane);
    for (int row = half + gw; row < nrows; row += NGW) p0_norm_row(p, HB, HM, row, lane);
}

__device__ __forceinline__ void meta_proj(const Params& p, int lane, int wave) {
    const bf16_t* W1T = (const bf16_t*)(p.ws + WS_W1T); const bf16_t* HM = (const bf16_t*)(p.ws + WS_HM); float* PM = (float*)(p.ws + WS_PROJM);
    const int gw = blockIdx.x * 8 + wave, NGW = gridDim.x * 8, fr = lane & 15, fq = lane >> 4;
    for (int j = gw; j < NPROJ / 16; j += NGW) {
        const int n0 = 16 * j; f32x4 acc = {0.f, 0.f, 0.f, 0.f};
        const bf16_t* wa = W1T + (size_t)(n0 + fr) * 1024 + 8 * fq; const bf16_t* hb = HM + (size_t)fr * 1024 + 8 * fq;
#pragma unroll 4
        for (int kk = 0; kk < 32; ++kk) { const bf16x8 a = *(const bf16x8*)(wa + 32 * kk), b = *(const bf16x8*)(hb + 32 * kk);
            acc = __builtin_amdgcn_mfma_f32_16x16x32_bf16(a, b, acc, 0, 0, 0); }
        *(f32x4*)(PM + (size_t)fr * NPROJ + n0 + 4 * fq) = acc;
        if (n0 < 1024) { u32x2 w; w.x = pk2(acc[0], acc[1]); w.y = pk2(acc[2], acc[3]); *(u32x2*)((bf16_t*)(p.ws + WS_UM) + (size_t)fr * 1024 + n0 + 4 * fq) = w; }
    }
}

constexpr int AT_NS = 9;
constexpr int AT_KR = 0, AT_VR = AT_NS * 8192, AT_KM = 2 * AT_NS * 8192, AT_VM = AT_KM + 2048, AT_RPB = AT_VM + 2048, AT_END = AT_RPB + 2048;
static_assert(AT_END <= LDS_BYTES, "attention LDS map");
constexpr float LOG2E = 1.4426950408889634f;

__device__ __forceinline__ void attn_load_row(const bf16_t* P5, int seqbase, int R, int h, int tid, u32x4& kv, u32x4& vv) {
    const int col = tid >> 3, ch = tid & 7;
    const bf16_t* src = P5 + (size_t)(seqbase + R * 64 + col) * LDP5 + h * 64 + ch * 8;
    kv = __builtin_nontemporal_load((const u32x4*)(src + 2048)); vv = __builtin_nontemporal_load((const u32x4*)(src + 3072));
}
__device__ __forceinline__ void attn_write_row(LAS unsigned char* lds, int R, int tid, const u32x4 kv, const u32x4 vv) {
    const int col = tid >> 3, ch = tid & 7, slot = R % AT_NS;
    *(LAS u32x4*)(lds + AT_KR + slot * 8192 + col * 128 + ((ch ^ ((col >> 1) & 7)) << 4)) = kv;
#pragma unroll
    for (int i = 0; i < 8; ++i) { const int d = 8 * ch + i; const int sw = ((d >> 1) ^ (d >> 3)) & 7; const int pg = (col >> 2) ^ (sw << 1);
        const unsigned w = vv[i >> 1]; const unsigned short val = (unsigned short)((i & 1) ? (w >> 16) : (w & 0xffffu));
        *(LAS unsigned short*)(lds + AT_VR + slot * 8192 + d * 128 + pg * 8 + (col & 3) * 2) = val; }
}

__device__ __forceinline__ void attn_phase(const Params& p, LAS unsigned char* lds, int tid, int lane, int wave, bf16_t* OB, int ldo) {
    const bf16_t* P5 = (const bf16_t*)(p.ws + WS_P5); const float* PM = (const float*)(p.ws + WS_PROJM);
    const int fr = lane & 15, fq = lane >> 4, qg = wave & 3, rsel = wave >> 2;
    const int c0 = (qg == 0) ? 0 : (qg == 1 ? 8 : (qg == 2 ? 24 : 32));
    const int cq = 16 * qg + fr;
    const int cst = min(max(cq - 8, 0), 48);
    LAS float* rpbL = (LAS float*)(lds + AT_RPB);
    int kad[2][2], vad[4][2];
#pragma unroll
    for (int blk = 0; blk < 2; ++blk) { const int col = c0 + 16 * blk + fr, sw = (col >> 1) & 7; kad[blk][0] = col * 128 + ((fq ^ sw) << 4); kad[blk][1] = col * 128 + (((4 + fq) ^ sw) << 4); }
#pragma unroll
    for (int db = 0; db < 4; ++db) { const int d = 16 * db + fr, sw = ((d >> 1) ^ (d >> 3)) & 7, g0 = (c0 >> 2) + fq; vad[db][0] = d * 128 + ((g0 ^ (sw << 1)) << 3); vad[db][1] = d * 128 + (((g0 + 4) ^ (sw << 1)) << 3); }
    const int kmad0 = fr * 128 + ((fq ^ ((fr >> 1) & 7)) << 4), kmad1 = fr * 128 + (((4 + fq) ^ ((fr >> 1) & 7)) << 4);
    for (int run = blockIdx.x; run < 768; run += gridDim.x) {
        int s, h, rb, rows;
        if (run < 256) { s = run >> 5; const int rem = run & 31; h = rem >> 1; rb = rem & 1; rows = 32; }
        else { const int idx = run - 256; s = 8 + (idx >> 7); const int rem = idx & 127; h = rem >> 3; rb = rem & 7; rows = 128; }
        const int seqbase = s < 8 ? s * 2048 : MP + (s - 8) * 8192;
        const int r0 = rb * 16;
        __syncthreads();
        const int rs0 = min(max(r0 - 4, 0), rows - 8);
        {
            u32x4 kv[AT_NS], vv[AT_NS];
#pragma unroll
            for (int j = 0; j < AT_NS; ++j) attn_load_row(P5, seqbase, rs0 + j, h, tid, kv[j], vv[j]);
            for (int i = tid; i < 465; i += 512) rpbL[i] = p.rpb[h * 465 + i] * LOG2E;
            if (tid < 16) rpbL[480 + tid] = p.meta_bias[h * 16 + tid] * LOG2E;
            for (int i = tid; i < 1024; i += 512) { const int m = i >> 6, d = i & 63;
                const float kf = PM[(size_t)m * NPROJ + 3072 + h * 64 + d], vf = PM[(size_t)m * NPROJ + 4096 + h * 64 + d];
                *(LAS unsigned short*)(lds + AT_KM + m * 128 + (((d >> 3) ^ ((m >> 1) & 7)) << 4) + (d & 7) * 2) = (unsigned short)f2bf(kf);
                *(LAS unsigned short*)(lds + AT_VM + d * 32 + m * 2) = (unsigned short)f2bf(vf); }
#pragma unroll
            for (int j = 0; j < AT_NS; ++j) attn_write_row(lds, rs0 + j, tid, kv[j], vv[j]);
        }
        int res_hi = rs0 + AT_NS;
        u32x2 binit[8][2]; int cur_delta = -1;
        f32x4 mbinit = {0.f, 0.f, 0.f, 0.f};
        size_t tok = (size_t)(seqbase + (r0 + rsel) * 64 + cq);
        bf16x8 q0 = *(const bf16x8*)(P5 + tok * LDP5 + 1024 + h * 64 + 8 * fq), q1 = *(const bf16x8*)(P5 + tok * LDP5 + 1024 + h * 64 + 32 + 8 * fq);
        u32x2 gt[4];
#pragma unroll
        for (int db = 0; db < 4; ++db) gt[db] = *(const u32x2*)(P5 + tok * LDP5 + 4096 + h * 64 + 16 * db + 4 * fq);
        for (int ra = r0; ra < r0 + 16; ra += 2) {
            const int r = ra + rsel;
            const int rs = min(max(r - 4, 0), rows - 8);
            const bool more = (ra + 2 < r0 + 16);
            int nnewN = 0, needN = res_hi; const size_t tokN = tok + 128;
            u32x4 kaN = {0u, 0u, 0u, 0u}, vaN = kaN, kbN = kaN, vbN = kaN; bf16x8 q0N = q0, q1N = q1; u32x2 gtN[4] = {gt[0], gt[1], gt[2], gt[3]};
            if (more) {
                needN = min(max(ra + 3 - 4, 0), rows - 8) + 8; nnewN = needN - res_hi;
                if (nnewN >= 1) attn_load_row(P5, seqbase, res_hi, h, tid, kaN, vaN);
                if (nnewN >= 2) attn_load_row(P5, seqbase, res_hi + 1, h, tid, kbN, vbN);
                q0N = *(const bf16x8*)(P5 + tokN * LDP5 + 1024 + h * 64 + 8 * fq); q1N = *(const bf16x8*)(P5 + tokN * LDP5 + 1024 + h * 64 + 32 + 8 * fq);
#pragma unroll
                for (int db = 0; db < 4; ++db) gtN[db] = *(const u32x2*)(P5 + tokN * LDP5 + 4096 + h * 64 + 16 * db + 4 * fq);
            }
            __syncthreads();
            if (r - rs != cur_delta) {
                cur_delta = r - rs;
#pragma unroll
                for (int k8 = 0; k8 < 8; ++k8) { const int roff = (k8 + 7 - cur_delta) * 31;
#pragma unroll
                    for (int blk = 0; blk < 2; ++blk) { float bb[4];
#pragma unroll
                        for (int i = 0; i < 4; ++i) { const int kc = c0 + 16 * blk + 4 * fq + i; const bool ok = (unsigned)(kc - cst) < 16u; const int co = ok ? (kc - cq + 15) : 0;
                            const float b = rpbL[roff + co]; bb[i] = ok ? b : -30000.0f; }
                        binit[k8][blk].x = pg8::cvt_pk_bf16(bb[0], bb[1]); binit[k8][blk].y = pg8::cvt_pk_bf16(bb[2], bb[3]); } }
#pragma unroll
                for (int i = 0; i < 4; ++i) mbinit[i] = rpbL[480 + 4 * fq + i];
            }
            const int slot0 = rs % AT_NS;
            int sbase[8];
#pragma unroll
            for (int k8 = 0; k8 < 8; ++k8) { int slot = slot0 + k8; slot = slot >= AT_NS ? slot - AT_NS : slot; sbase[k8] = slot * 8192; }
            float mrun = -INFINITY;
            f32x4 O[4]; f32x4 L4 = {0.f, 0.f, 0.f, 0.f};
            const bf16x8 ones = {(short)0x3F80, (short)0x3F80, (short)0x3F80, (short)0x3F80, (short)0x3F80, (short)0x3F80, (short)0x3F80, (short)0x3F80};
#pragma unroll
            for (int db = 0; db < 4; ++db) O[db] = (f32x4){0.f, 0.f, 0.f, 0.f};
#pragma unroll
            for (int hf = 0; hf < 2; ++hf) {
                f32x4 S[4][2]; f32x4 Sm = mbinit;
                {
                    bf16x8 kf[2][2][2];
#define AT_RDK(buf, k8_) do { const LAS unsigned char* kbp = lds + AT_KR + sbase[k8_]; \
                    _Pragma("unroll") for (int blk = 0; blk < 2; ++blk) { kf[buf][blk][0] = *(const LAS bf16x8*)(kbp + kad[blk][0]); kf[buf][blk][1] = *(const LAS bf16x8*)(kbp + kad[blk][1]); } } while (0)
                    AT_RDK(0, 4 * hf);
#pragma unroll
                    for (int k4 = 0; k4 < 4; ++k4) {
                        if (k4 < 3) AT_RDK((k4 + 1) & 1, 4 * hf + k4 + 1);
                        __builtin_amdgcn_sched_barrier(0);
                        __builtin_amdgcn_s_setprio(1);
#pragma unroll
                        for (int blk = 0; blk < 2; ++blk) { const u32x2 bp = binit[4 * hf + k4][blk]; f32x4 a = {bflo(bp.x), bfhi(bp.x), bflo(bp.y), bfhi(bp.y)};
                            a = __builtin_amdgcn_mfma_f32_16x16x32_bf16(kf[k4 & 1][blk][0], q0, a, 0, 0, 0);
                            a = __builtin_amdgcn_mfma_f32_16x16x32_bf16(kf[k4 & 1][blk][1], q1, a, 0, 0, 0);
                            S[k4][blk] = a; }
                        __builtin_amdgcn_s_setprio(0);
                        __builtin_amdgcn_sched_barrier(0);
                    }
#undef AT_RDK
                }
                float mloc = -INFINITY;
                if (hf == 0) {
                    const bf16x8 k0 = *(const LAS bf16x8*)(lds + AT_KM + kmad0), k1 = *(const LAS bf16x8*)(lds + AT_KM + kmad1);
                    Sm = __builtin_amdgcn_mfma_f32_16x16x32_bf16(k0, q0, Sm, 0, 0, 0);
                    Sm = __builtin_amdgcn_mfma_f32_16x16x32_bf16(k1, q1, Sm, 0, 0, 0);
                    mloc = fmaxf(fmaxf(Sm[0], Sm[1]), fmaxf(Sm[2], Sm[3]));
                }
#pragma unroll
                for (int k4 = 0; k4 < 4; ++k4)
#pragma unroll
                    for (int blk = 0; blk < 2; ++blk) { const f32x4 a = S[k4][blk]; mloc = __builtin_fmaxf(__builtin_fmaxf(mloc, a[0]), a[1]); mloc = __builtin_fmaxf(__builtin_fmaxf(mloc, a[2]), a[3]); }
                mloc = fmaxf(mloc, __shfl_xor(mloc, 16)); mloc = fmaxf(mloc, __shfl_xor(mloc, 32));
                const float mx = fmaxf(mrun, mloc);
                if (hf == 1) { const float alpha = __builtin_amdgcn_exp2f(mrun - mx); L4 = L4 * alpha;
#pragma unroll
                    for (int db = 0; db < 4; ++db) O[db] = O[db] * alpha; }
                mrun = mx;
                {
                    u32x2 vf[2][4][2];
#define AT_RDV(buf, k8_) do { const LAS unsigned char* vbp = lds + AT_VR + sbase[k8_]; _Pragma("unroll") for (int db = 0; db < 4; ++db) { \
                    vf[buf][db][0] = *(const LAS u32x2*)(vbp + vad[db][0]); vf[buf][db][1] = *(const LAS u32x2*)(vbp + vad[db][1]); } } while (0)
                    AT_RDV(0, 4 * hf);
#pragma unroll
                    for (int k4 = 0; k4 < 4; ++k4) {
                        if (k4 < 3) AT_RDV((k4 + 1) & 1, 4 * hf + k4 + 1);
                        __builtin_amdgcn_sched_barrier(0);
                        float pv[8];
#pragma unroll
                        for (int blk = 0; blk < 2; ++blk)
#pragma unroll
                            for (int i = 0; i < 4; i += 2) { const f32x2 d = (f32x2){S[k4][blk][i], S[k4][blk][i + 1]} - (f32x2){mx, mx};
                                pv[blk * 4 + i] = __builtin_amdgcn_exp2f(d.x); pv[blk * 4 + i + 1] = __builtin_amdgcn_exp2f(d.y); }
                        u32x4 pw; pw.x = pg8::cvt_pk_bf16(pv[0], pv[1]); pw.y = pg8::cvt_pk_bf16(pv[2], pv[3]); pw.z = pg8::cvt_pk_bf16(pv[4], pv[5]); pw.w = pg8::cvt_pk_bf16(pv[6], pv[7]);
                        const bf16x8 pf = __builtin_bit_cast(bf16x8, pw);
                        __builtin_amdgcn_s_setprio(1);
#pragma unroll
                        for (int db = 0; db < 4; ++db) { u32x4 vw; vw.x = vf[k4 & 1][db][0].x; vw.y = vf[k4 & 1][db][0].y; vw.z = vf[k4 & 1][db][1].x; vw.w = vf[k4 & 1][db][1].y;
                            O[db] = __builtin_amdgcn_mfma_f32_16x16x32_bf16(__builtin_bit_cast(bf16x8, vw), pf, O[db], 0, 0, 0); }
                        L4 = __builtin_amdgcn_mfma_f32_16x16x32_bf16(ones, pf, L4, 0, 0, 0);
                        __builtin_amdgcn_s_setprio(0);
                        __builtin_amdgcn_sched_barrier(0);
                    }
#undef AT_RDV
                }
                if (hf == 0) {
                    float pv[4];
#pragma unroll
                    for (int i = 0; i < 4; ++i) pv[i] = __builtin_amdgcn_exp2f(Sm[i] - mx);
                    u32x4 pw; pw.x = pg8::cvt_pk_bf16(pv[0], pv[1]); pw.y = pg8::cvt_pk_bf16(pv[2], pv[3]); pw.z = 0u; pw.w = 0u;
                    const bf16x8 pf = __builtin_bit_cast(bf16x8, pw);
#pragma unroll
                    for (int db = 0; db < 4; ++db) { const int d = 16 * db + fr; const u32x2 x0 = *(const LAS u32x2*)(lds + AT_VM + d * 32 + fq * 8);
                        u32x4 vw; vw.x = x0.x; vw.y = x0.y; vw.z = 0u; vw.w = 0u;
                        O[db] = __builtin_amdgcn_mfma_f32_16x16x32_bf16(__builtin_bit_cast(bf16x8, vw), pf, O[db], 0, 0, 0); }
                    L4 = __builtin_amdgcn_mfma_f32_16x16x32_bf16(ones, pf, L4, 0, 0, 0);
                }
            }
            const float lsum = L4[0];
            __syncthreads();
            {
                const float inv = __builtin_amdgcn_rcpf(lsum);
#pragma unroll
                for (int db = 0; db < 4; ++db) { float o[4];
                    const float g0 = bflo(gt[db].x), g1 = bfhi(gt[db].x), g2 = bflo(gt[db].y), g3 = bfhi(gt[db].y);
                    o[0] = O[db][0] * inv * g0 * __builtin_amdgcn_rcpf(1.f + __expf(-g0)); o[1] = O[db][1] * inv * g1 * __builtin_amdgcn_rcpf(1.f + __expf(-g1));
                    o[2] = O[db][2] * inv * g2 * __builtin_amdgcn_rcpf(1.f + __expf(-g2)); o[3] = O[db][3] * inv * g3 * __builtin_amdgcn_rcpf(1.f + __expf(-g3));
                    u32x2 w; w.x = pg8::cvt_pk_bf16(o[0], o[1]); w.y = pg8::cvt_pk_bf16(o[2], o[3]);
                    *(u32x2*)(OB + tok * ldo + h * 64 + 16 * db + 4 * fq) = w; }
            }
            if (nnewN >= 1) attn_write_row(lds, res_hi, tid, kaN, vaN);
            if (nnewN >= 2) attn_write_row(lds, res_hi + 1, tid, kbN, vbN);
            if (nnewN > 0) res_hi = needN;
            q0 = q0N; q1 = q1N; tok = tokN;
#pragma unroll
            for (int db = 0; db < 4; ++db) gt[db] = gtN[db];
        }
    }
    __syncthreads();
}

template <int CH> struct PackT;
template <> struct PackT<8> { typedef u32x4 type; };
template <> struct PackT<4> { typedef u32x2 type; };
__device__ __forceinline__ void unpackv(const u32x4 w, float (&v)[8]) {
    v[0] = bflo(w.x); v[1] = bfhi(w.x); v[2] = bflo(w.y); v[3] = bfhi(w.y); v[4] = bflo(w.z); v[5] = bfhi(w.z); v[6] = bflo(w.w); v[7] = bfhi(w.w);
}
__device__ __forceinline__ void unpackv(const u32x2 w, float (&v)[4]) { v[0] = bflo(w.x); v[1] = bfhi(w.x); v[2] = bflo(w.y); v[3] = bfhi(w.y); }
__device__ __forceinline__ void packv(const float (&o)[8], u32x4& w) { w.x = pg8::cvt_pk_bf16(o[0], o[1]); w.y = pg8::cvt_pk_bf16(o[2], o[3]); w.z = pg8::cvt_pk_bf16(o[4], o[5]); w.w = pg8::cvt_pk_bf16(o[6], o[7]); }
__device__ __forceinline__ void packv(const float (&o)[4], u32x2& w) { w.x = pg8::cvt_pk_bf16(o[0], o[1]); w.y = pg8::cvt_pk_bf16(o[2], o[3]); }
template <int HALF, int TS, int CH>
__device__ __forceinline__ void pool_task(const bf16_t* U, const bf16_t* UM, const bf16_t* P5, const float* pool_scale, int seqbase, int T, int t0, int n0, bf16_t* OB, int ldo) {
    typedef typename PackT<CH>::type V;
    constexpr int NR = TS + 2 * HALF;
    asm volatile("" : "+v"(n0), "+v"(t0));
    V rows[NR];
    const bf16_t* base = U + ((long)(seqbase + t0) - HALF) * 1024 + n0;
    const bool first = (t0 == 0);
#pragma unroll
    for (int i = 0; i < NR; ++i) {
        const bf16_t* src = base + (long)i * 1024;
        if (i < HALF) src = first ? UM + (size_t)(16 - HALF + i) * 1024 + n0 : src;
        V w = *(const V*)src;
        if (i >= TS + HALF) { if (t0 - HALF + i >= T) w = V{}; }
        rows[i] = w; }
    float ps[CH];
#pragma unroll
    for (int c = 0; c < CH; c += 4) { const f32x4 a = *(const f32x4*)(pool_scale + n0 + c); ps[c] = a.x; ps[c + 1] = a.y; ps[c + 2] = a.z; ps[c + 3] = a.w; }
    float sum[CH];
#pragma unroll
    for (int i = 0; i < CH; ++i) sum[i] = 0.f;
#pragma unroll
    for (int i = 0; i < 2 * HALF; ++i) { float v[CH]; unpackv(rows[i], v);
#pragma unroll
        for (int c = 0; c < CH; ++c) sum[c] += v[c]; }
#pragma unroll
    for (int hb = 0; hb < TS / 8; ++hb) {
        V gts[8];
#pragma unroll
        for (int k = 0; k < 8; ++k) gts[k] = *(const V*)(P5 + (size_t)(seqbase + t0 + hb * 8 + k) * LDP5 + n0);
#pragma unroll
        for (int k8 = 0; k8 < 8; ++k8) { const int k = hb * 8 + k8; const int t = t0 + k;
            const int cnt = min(t + HALF, T) - (t - HALF); const float ic = __builtin_amdgcn_rcpf((float)cnt);
            float ctr[CH], add[CH], sub[CH], gv[CH]; unpackv(rows[k + HALF], ctr); unpackv(rows[k + 2 * HALF], add); unpackv(rows[k], sub); unpackv(gts[k8], gv);
            float o[CH];
#pragma unroll
            for (int c = 0; c < CH; c += 2) {
                const f32x2 gg = {gv[c], gv[c + 1]}, sm = {sum[c], sum[c + 1]}, ct = {ctr[c], ctr[c + 1]}, pp = {ps[c], ps[c + 1]};
                const f32x2 tt = gg * (-1.4426950408889634f); f32x2 den; den.x = __builtin_amdgcn_exp2f(tt.x); den.y = __builtin_amdgcn_exp2f(tt.y); den = den + 1.0f;
                f32x2 sg; sg.x = __builtin_amdgcn_rcpf(den.x); sg.y = __builtin_amdgcn_rcpf(den.y);
                const f32x2 r = (sm * ic - ct) * pp * (gg * sg);
                o[c] = r.x; o[c + 1] = r.y; sum[c] += add[c] - sub[c]; sum[c + 1] += add[c + 1] - sub[c + 1]; }
            V w; packv(o, w);
            *(V*)(OB + (size_t)(seqbase + t) * ldo + n0) = w;
            __builtin_amdgcn_sched_barrier(0); }
    }
}
__device__ __forceinline__ void pool_phase(const Params& p, int lane, int wave, bf16_t* OB, int ldo) {
    const bf16_t* U = (const bf16_t*)((const unsigned char*)p.out + OUT_U); const bf16_t* P5 = (const bf16_t*)(p.ws + WS_P5); const bf16_t* UM = (const bf16_t*)(p.ws + WS_UM);
    const int gw = blockIdx.x * 8 + wave, NGW = gridDim.x * 8;
    for (int task = gw; task < (MR / 32) * 4; task += NGW) {
        const int g = task & 3, st = task >> 2, tw = st * 32;
        int seqbase, T; if (tw < MP) { seqbase = tw & ~2047; T = 2048; } else { seqbase = MP + ((tw - MP) & ~8191); T = 8192; }
        const int t0 = tw - seqbase + (lane >> 5) * 16, n0 = g * 256 + (lane & 31) * 8;
        if (g == 0) pool_task<1, 16, 8>(U, UM, P5, p.pool_scale, seqbase, T, t0, n0, OB, ldo);
        else if (g == 1) pool_task<2, 16, 8>(U, UM, P5, p.pool_scale, seqbase, T, t0, n0, OB, ldo);
        else if (g == 2) { pool_task<4, 8, 8>(U, UM, P5, p.pool_scale, seqbase, T, t0, n0, OB, ldo); asm volatile("" ::: "memory"); pool_task<4, 8, 8>(U, UM, P5, p.pool_scale, seqbase, T, t0 + 8, n0, OB, ldo); }
        else { const int tu = tw - seqbase, n4 = 768 + lane * 4;
            pool_task<8, 16, 4>(U, UM, P5, p.pool_scale, seqbase, T, tu, n4, OB, ldo); asm volatile("" ::: "memory"); pool_task<8, 16, 4>(U, UM, P5, p.pool_scale, seqbase, T, tu + 16, n4, OB, ldo); }
    }
}

__device__ __forceinline__ void final_norm(const Params& p, int lane, int wave) {
    const float* ssq = (const float*)(p.ws + WS_SSQ); const f32x4* g4 = (const f32x4*)p.final_g + lane;
    const int gw = blockIdx.x * 8 + wave, NGW = gridDim.x * 8;
    f32x4 gg[4];
#pragma unroll
    for (int j = 0; j < 4; ++j) gg[j] = g4[64 * j];
    for (int row = gw; row < MR; row += NGW) {
        float s = lane < 16 ? ssq[(size_t)row * 16 + lane] : 0.f; s = wave_sum(s);
        const float rstd = 1.0f / sqrtf(s * (1.f / DM) + RMS_EPS);
        f32x4* o = (f32x4*)(p.out + (size_t)row * DM) + lane;
#pragma unroll
        for (int j = 0; j < 4; ++j) { const f32x4 v = o[64 * j]; o[64 * j] = v * rstd * gg[j]; }
    }
}

#define XB_TMO      128
#define XB_XCNT(j)  (256  + 64 * (j))
#define XB_XSUB(j)  (1280 + 64 * (j))
#define XB_XGEN(j)  (2304 + 64 * (j))
#define XB_TOP      3328
#define XB_TOPGEN   3392
#define XCD_BAR_WORDS 3456
#define XB_SPIN_CAP (1u << 18)

__device__ __forceinline__ unsigned xb_ld(unsigned* p)              { return __hip_atomic_load(p, __ATOMIC_RELAXED, __HIP_MEMORY_SCOPE_AGENT); }
__device__ __forceinline__ unsigned xb_add(unsigned* p, unsigned v) { return __hip_atomic_fetch_add(p, v, __ATOMIC_RELAXED, __HIP_MEMORY_SCOPE_AGENT); }
__device__ __forceinline__ unsigned xb_xcc_id() { return (unsigned)__builtin_amdgcn_s_getreg((3 << 11) | 20) & 0xFu; }
#define XB_SPIN(cond, bar) do { unsigned _sp = 0; while (cond) { __builtin_amdgcn_s_sleep(1); \
    if ((++_sp & 255u) == 0u) { if (xb_ld(&(bar)[XB_TMO])) break; if (_sp > XB_SPIN_CAP) { atomicAdd(&(bar)[XB_TMO], 1u); break; } } } } while (0)

struct XcdBarrier {
    unsigned* bar; unsigned x;
    volatile LAS unsigned* st;
};

__device__ __forceinline__ XcdBarrier xcd_barrier_post(unsigned* bar, volatile LAS unsigned* st) {
    XcdBarrier b; b.bar = bar; b.x = xb_xcc_id(); b.st = st;
    if (threadIdx.x == 0) (void)xb_add(&bar[XB_XCNT(b.x)], 1u);
    return b;
}
__device__ __forceinline__ void xcd_barrier_complete(unsigned* bar, unsigned x, unsigned& nloc, unsigned& nx) {
    const unsigned G = gridDim.x * gridDim.y * gridDim.z;
    unsigned sum, cnt, mine, sp = 0u;
    for (;;) {
        sum = 0u; cnt = 0u; mine = 0u;
#pragma unroll
        for (unsigned j = 0; j < 16; ++j) { const unsigned c = xb_ld(&bar[XB_XCNT(j)]); sum += c; cnt += (c > 0u) ? 1u : 0u; mine = (j == x) ? c : mine; }
        if (sum == G) break;
        __builtin_amdgcn_s_sleep(1);
        if ((++sp & 255u) == 0u) { if (xb_ld(&bar[XB_TMO])) break; if (sp > XB_SPIN_CAP) { atomicAdd(&bar[XB_TMO], 1u); break; } }
    }
    nloc = mine > 0u ? mine : 1u; nx = cnt > 0u ? cnt : 1u;
}

__device__ __forceinline__ void xcd_barrier(const XcdBarrier& b) {
    asm volatile("s_waitcnt vmcnt(0)" ::: "memory");
    __syncthreads();
    if (threadIdx.x == 0) {
        unsigned* bar = b.bar;
        __builtin_amdgcn_s_waitcnt(0);
        unsigned nloc = b.st[0], nx = b.st[1];
        if (nloc == 0u) { xcd_barrier_complete(bar, b.x, nloc, nx); b.st[0] = nloc; b.st[1] = nx; }
        const unsigned old = xb_add(&bar[XB_XSUB(b.x)], 1u);
        const unsigned gen = old / nloc;
        if (old + 1u == (gen + 1u) * nloc) {
            __builtin_amdgcn_fence(__ATOMIC_RELEASE, "agent");
            asm volatile("s_waitcnt vmcnt(0)" ::: "memory");
            const unsigned og = xb_add(&bar[XB_TOP], 1u);
            const unsigned tg = og / nx;
            if (og + 1u == (tg + 1u) * nx) xb_add(&bar[XB_TOPGEN], 1u);
            else XB_SPIN(xb_ld(&bar[XB_TOPGEN]) == tg, bar);
            __builtin_amdgcn_fence(__ATOMIC_ACQUIRE, "agent");
            xb_add(&bar[XB_XGEN(b.x)], 1u);
            asm volatile("s_waitcnt vmcnt(0)" ::: "memory");
        } else {
            XB_SPIN(xb_ld(&bar[XB_XGEN(b.x)]) == gen, bar);
            __builtin_amdgcn_fence(__ATOMIC_ACQUIRE, "agent");
            asm volatile("s_waitcnt vmcnt(0)" ::: "memory");
        }
    }
    __syncthreads();
}


__global__ void __launch_bounds__(512) fwd_megakernel(Params p) {
    extern __shared__ __attribute__((aligned(16))) unsigned char lds_raw[];
    LAS unsigned char* lds = (LAS unsigned char*)lds_raw;
    cg::grid_group grid = cg::this_grid();
    const int tid = threadIdx.x, lane = tid & 63, wave = __builtin_amdgcn_readfirstlane(tid >> 6);
    const int lo = p.ph_lo, hi = p.ph_hi;
#define IN(k) (lo <= (k) && (k) < hi)
    volatile LAS unsigned* bst = (volatile LAS unsigned*)(lds + LDS_BYTES - 64);
    if (tid < 2) bst[tid] = 0u;
    __syncthreads();
    XcdBarrier xbar; xbar.bar = (unsigned*)(p.ws + WS_BAR); xbar.x = 0; xbar.st = bst;
#define SEAM(k) do { if (IN(k) && IN((k) + 1)) { if ((k) == 0) grid.sync(); else xcd_barrier(xbar); } } while (0)
#if MK_N_LAUNCHES == 1
    if (blockIdx.x == 0) { unsigned* cw = (unsigned*)(p.ws + WS_CNT); for (int i = tid; i < (65536 + 16384) / 4; i += 512) cw[i] = 0u; }
#endif
#ifndef PROBE_DUP
#define PROBE_DUP 0
#endif
    if (IN(0)) { p0_prologue(p, lds, tid, lane, wave); if (PROBE_DUP == 5) p0_prologue(p, lds, tid, lane, wave); }
    SEAM(0);
    if (IN(0) && IN(1)) xbar = xcd_barrier_post((unsigned*)(p.ws + WS_BAR), bst);
    if (IN(1)) {
        meta_proj(p, lane, wave);
        pg8::Gemm g{(const bf16_t*)((const unsigned char*)p.out + OUT_HB), (const bf16_t*)(p.ws + WS_W1T), MR, NPROJ, 1024, 1024};
        pg8::StaticOrder S; S.init(MR, NPROJ, gridDim.x, blockIdx.x);
        pg8::EpiProj E{(bf16_t*)((unsigned char*)p.out + OUT_U), (bf16_t*)(p.ws + WS_P5)};
        pg8::gemm_phase<pg8::EpiProj, pg8::StaticOrder, true>(lds, g, S, E);
        if (PROBE_DUP == 1) pg8::gemm_phase<pg8::EpiProj, pg8::StaticOrder, true>(lds, g, S, E);
    }
    SEAM(1);
    if (IN(2)) {
        bf16_t* P5o = (bf16_t*)(p.ws + WS_P5); bf16_t* SCR = (bf16_t*)((unsigned char*)p.out + OUT_HB);
        if (PROBE_DUP == 2) attn_phase(p, lds, tid, lane, wave, SCR, 1024);
        if (PROBE_DUP == 3) pool_phase(p, lane, wave, SCR, 1024);
        if (blockIdx.x & 1) pool_phase(p, lane, wave, P5o, LDP5);
        attn_phase(p, lds, tid, lane, wave, P5o + 1024, LDP5);
        if (!(blockIdx.x & 1)) pool_phase(p, lane, wave, P5o, LDP5);
    }
    SEAM(2);
    if (IN(3)) {
        pg8::Gemm g{(const bf16_t*)(p.ws + WS_P5), (const bf16_t*)(p.ws + WS_W2T), MR, 1024, 2048, LDP5};
#if FUSE_NORM
        pg8::PanelOrder S; S.init(MR, 1024, gridDim.x, blockIdx.x);
        pg8::EpiOutN E{p.xp, p.xs, p.out, (float*)(p.ws + WS_SSQ), (unsigned*)(p.ws + WS_CNT), p.final_g, lds + 131072};
        pg8::gemm_phase<pg8::EpiOutN, pg8::PanelOrder, true>(lds, g, S, E);
#else
        pg8::StaticOrder S; S.init(MR, 1024, gridDim.x, blockIdx.x);
        pg8::EpiOut E{p.xp, p.xs, p.out, (float*)(p.ws + WS_SSQ)};
        pg8::gemm_phase<pg8::EpiOut, pg8::StaticOrder, true>(lds, g, S, E);
        if (PROBE_DUP == 4) pg8::gemm_phase<pg8::EpiOut, pg8::StaticOrder, true>(lds, g, S, E);
#endif
    }
#if !FUSE_NORM
    SEAM(3);
    if (IN(4)) { final_norm(p, lane, wave); }
#endif
#undef IN
#undef SEAM
}

extern "C" void kernel_launch(void* const* d_in, const int* in_sizes, int n_in, void* d_out, int out_size, void* d_ws, size_t ws_size, hipStream_t stream) {
    static int grid = 0;
    if (grid == 0) {
        if (n_in != 11 || out_size != MR * DM || ws_size < WS_END) { fprintf(stderr, "kernel_launch: unexpected shapes: n_in %d out %d ws %zu (need %zu)\n", n_in, out_size, ws_size, (size_t)WS_END); grid = -1; return; }
        int dev = 0, cus = 0, per_cu = 0;
        if (hipGetDevice(&dev) != hipSuccess || hipDeviceGetAttribute(&cus, hipDeviceAttributeMultiprocessorCount, dev) != hipSuccess) { grid = -1; return; }
        if (hipFuncSetAttribute((const void*)fwd_megakernel, hipFuncAttributeMaxDynamicSharedMemorySize, LDS_BYTES) != hipSuccess) { fprintf(stderr, "kernel_launch: hipFuncSetAttribute failed\n"); grid = -1; return; }
        if (hipOccupancyMaxActiveBlocksPerMultiprocessor(&per_cu, (const void*)fwd_megakernel, 512, LDS_BYTES) != hipSuccess || per_cu < 1) { fprintf(stderr, "kernel_launch: occupancy query failed (%d)\n", per_cu); grid = -1; return; }
        grid = cus * per_cu;
    }
    if (grid < 0) return;
    Params p{};
    p.xp = (const float*)d_in[0]; p.xs = (const float*)d_in[1]; p.meta = (const float*)d_in[2]; p.norm_g = (const float*)d_in[3]; p.w_in = (const float*)d_in[4];
    p.w_pool = (const float*)d_in[5]; p.pool_scale = (const float*)d_in[6]; p.rpb = (const float*)d_in[7]; p.meta_bias = (const float*)d_in[8]; p.w_out = (const float*)d_in[9];
    p.final_g = (const float*)d_in[10]; p.out = (float*)d_out; p.ws = (unsigned char*)d_ws;
#if FUSE_NORM && MK_N_LAUNCHES != 1
    if (hipMemsetAsync((char*)d_ws + WS_CNT, 0, 65536 + 16384, stream) != hipSuccess) { fprintf(stderr, "kernel_launch: memset failed\n"); return; }
#endif
#if MK_N_LAUNCHES == 1
    p.ph_lo = 0; p.ph_hi = 5;
    void* args[] = {&p};
    hipError_t e = hipLaunchCooperativeKernel((const void*)fwd_megakernel, dim3(grid), dim3(512), args, LDS_BYTES, stream);
    if (e != hipSuccess) fprintf(stderr, "kernel_launch: cooperative launch failed: %s (grid %d)\n", hipGetErrorString(e), grid);
#else
    for (int i = 0; i < 5; ++i) { p.ph_lo = i; p.ph_hi = i + 1; hipLaunchKernelGGL(fwd_megakernel, dim3(grid), dim3(512), LDS_BYTES, stream, p); }
#endif
}
```

```cpp
#include <hip/hip_runtime.h>
#include <hip/hip_cooperative_groups.h>
#include <cstdio>
#include <cstdint>
namespace cg = cooperative_groups;

#ifndef MK_N_LAUNCHES
#define MK_N_LAUNCHES 1
#endif
#ifndef FUSE_NORM
#define FUSE_NORM 1
#endif

#define LAS __attribute__((address_space(3)))
typedef unsigned short bf16_t;
typedef short bf16x8 __attribute__((ext_vector_type(8)));
typedef float f32x4 __attribute__((ext_vector_type(4)));
typedef float f32x2 __attribute__((ext_vector_type(2)));
typedef unsigned u32x4 __attribute__((ext_vector_type(4)));
typedef unsigned u32x2 __attribute__((ext_vector_type(2)));

constexpr int DM = 1024;
constexpr int MR = 49152;
constexpr int MP = 16384;
constexpr int NPROJ = 6144;
constexpr int LDP5 = 5120;
constexpr int NMETA = 16;
constexpr float RMS_EPS = 1e-6f;

constexpr size_t MiB = 1u << 20;
constexpr size_t WS_W1T = 0;
constexpr size_t WS_W2T = 12 * MiB;
constexpr size_t WS_HM = 16 * MiB;
constexpr size_t WS_UM = 16 * MiB + 32768;
constexpr size_t WS_PROJM = 16 * MiB + 65536;
constexpr size_t WS_SSQ = 17 * MiB;
constexpr size_t WS_CNT = 19 * MiB;
constexpr size_t WS_BAR = 19 * MiB + 65536;
constexpr size_t WS_P5 = 20 * MiB;
constexpr size_t WS_END = WS_P5 + (size_t)MR * LDP5 * 2;
constexpr size_t OUT_U = 0, OUT_HB = (size_t)MR * 1024 * 2;

constexpr int LDS_BYTES = 160 * 1024;

__device__ __forceinline__ unsigned f2bf(float f) { unsigned u = __builtin_bit_cast(unsigned, f); return (u + 0x7fffu + ((u >> 16) & 1u)) >> 16; }
typedef __bf16 bf16x2_t __attribute__((ext_vector_type(2)));
__device__ __forceinline__ unsigned pk2(float lo, float hi) { const f32x2 v = {lo, hi}; return __builtin_bit_cast(unsigned, __builtin_convertvector(v, bf16x2_t)); }
__device__ __forceinline__ float bflo(unsigned w) { return __builtin_bit_cast(float, w << 16); }
__device__ __forceinline__ float bfhi(unsigned w) { return __builtin_bit_cast(float, w & 0xffff0000u); }
__device__ __forceinline__ float wave_sum(float v) {
#pragma unroll
    for (int o = 1; o < 64; o <<= 1) v += __shfl_xor(v, o);
    return v;
}
#define LDS_WAIT() asm volatile("s_waitcnt lgkmcnt(0)" ::: "memory")

namespace pg8 {
constexpr int BM = 256, BK = 64, HALF = 128, HTB = HALF * BK * 2, STAGE_BYTES = 8 * HTB, NXCD = 8, WGM = 8;
__host__ __device__ __forceinline__ int lds_byte(int r, int c) { const int st = (r >> 4) * 2 + (c >> 5), rr = r & 15, cc = c & 31, ob = rr * 64 + cc * 2; return st * 1024 + (ob ^ (((ob >> 9) & 1) << 5)); }
__host__ __device__ __forceinline__ void stage_rc(int b, int& R, int& C) { const int st = b / 1024, sb = b % 1024, swz = sb ^ (((sb >> 9) & 1) << 5); R = (st >> 1) * 16 + swz / 64; C = (st & 1) * 32 + (swz % 64) / 2; }
__host__ __device__ __forceinline__ int perm32(int rho) { const int n = rho >> 4, i = rho & 15; return 8 * (i >> 2) + 4 * n + (i & 3); }

struct Unit { int pm, pn; };
struct Gemm { const bf16_t* A; const bf16_t* Bt; int M, N, K, lda; };

struct StaticOrder {
    int nM, nN, nwg, G, c;
    __host__ __device__ void init(int M, int N, int G_, int c_) { nM = M / BM; nN = N / BM; nwg = nM * nN; G = G_; c = c_; }
    __host__ __device__ bool next(int i, Unit& u) const {
        const long L = (long)i * G + c; if (L >= nwg) return false;
        int wgid = (int)L; { const int q = nwg / NXCD, r = nwg % NXCD, xcd = wgid % NXCD, off = wgid / NXCD; wgid = (xcd < r ? xcd * (q + 1) : r * (q + 1) + (xcd - r) * q) + off; }
        const int nig = WGM * nN, gid = wgid / nig, fm = gid * WGM, gsz = (nM - fm) < WGM ? (nM - fm) : WGM;
        u.pm = fm + ((wgid % nig) % gsz); u.pn = (wgid % nig) / gsz; return true;
    }
};

__device__ __forceinline__ unsigned cvt_pk_bf16(float lo, float hi) { const f32x2 v = {lo, hi}; return __builtin_bit_cast(unsigned, __builtin_convertvector(v, bf16x2_t)); }

struct EpiProj {
    static constexpr bool PERM = true;
    bf16_t* U; bf16_t* P5;
    __device__ __forceinline__ void operator()(const f32x4 (&acc)[2][2][4][2], const Unit& u, int wr, int wc, int fr, int fq) const {
        const int row0 = u.pm * BM + wr * 64 + fr;
        bf16_t* base; int ldc, colt;
        if (u.pn < 4) { base = U; ldc = 1024; colt = u.pn * BM; } else { base = P5; ldc = LDP5; colt = u.pn * BM - 1024; }
        const int col0 = colt + wc * 32 + 8 * fq;
#pragma unroll
        for (int ai = 0; ai < 2; ++ai)
#pragma unroll
            for (int m = 0; m < 4; ++m) { bf16_t* rowp = base + (size_t)(row0 + ai * HALF + m * 16) * ldc + col0;
#pragma unroll
                for (int bj = 0; bj < 2; ++bj) { const f32x4 v0 = acc[ai][bj][m][0], v1 = acc[ai][bj][m][1];
                    u32x4 w; w.x = cvt_pk_bf16(v0[0], v0[1]); w.y = cvt_pk_bf16(v0[2], v0[3]); w.z = cvt_pk_bf16(v1[0], v1[1]); w.w = cvt_pk_bf16(v1[2], v1[3]);
                    *(u32x4*)(rowp + bj * HALF) = w; } }
    }
};
struct EpiOut {
    static constexpr bool PERM = false;
    const float* xp; const float* xs; float* out; float* ssq;
    __device__ __forceinline__ void operator()(const f32x4 (&acc)[2][2][4][2], const Unit& u, int wr, int wc, int fr, int fq) const {
        const int row0 = u.pm * BM + wr * 64 + fr, col0 = u.pn * BM + wc * 32 + 4 * fq;
#pragma unroll
        for (int ai = 0; ai < 2; ++ai)
#pragma unroll
            for (int m = 0; m < 4; ++m) { const int r = row0 + ai * HALF + m * 16;
                const float* xr = (r < MP) ? xp + (size_t)r * DM : xs + (size_t)(r - MP) * DM; float* orow = out + (size_t)r * DM; float s = 0.f;
#pragma unroll
                for (int bj = 0; bj < 2; ++bj)
#pragma unroll
                    for (int n = 0; n < 2; ++n) { const int c = col0 + bj * HALF + n * 16; const f32x4 v = acc[ai][bj][m][n] + *(const f32x4*)(xr + c);
                        *(f32x4*)(orow + c) = v; s += (v[0] * v[0] + v[1] * v[1]) + (v[2] * v[2] + v[3] * v[3]); }
                s += __shfl_xor(s, 16); s += __shfl_xor(s, 32);
                if (fq == 0) ssq[(size_t)r * 16 + u.pn * 4 + wc] = s;
                if (m & 1) asm volatile("" ::: "memory"); }
    }
};

struct PanelOrder {
    int nwg, G, c;
    __host__ __device__ void init(int M, int N, int G_, int bx) { nwg = (M / BM) * (N / BM); G = G_; c = (G_ % 8 == 0) ? (bx % 8) * (G_ / 8) + bx / 8 : bx; }
    __host__ __device__ bool next(int i, Unit& u) const { const long L = (long)i * G + c; if (L >= nwg) return false; u.pm = (int)(L >> 2); u.pn = (int)(L & 3); return true; }
};
struct EpiOutN {
    static constexpr bool PERM = false;
    const float* xp; const float* xs; float* out; float* xch; unsigned* cnt; const float* fg; LAS unsigned char* lx;
    __device__ __forceinline__ void operator()(f32x4 (&acc)[2][2][4][2], const Unit& u, int wr, int wc, int fr, int fq) const {
        const int tid = threadIdx.x, lane = tid & 63, wid = tid >> 6;
        LAS float* part = (LAS float*)lx;
        LAS float* rst = (LAS float*)(lx + 4096);
        const int row0 = u.pm * BM + wr * 64 + fr, col0 = u.pn * BM + wc * 32 + 4 * fq;
#pragma unroll
        for (int ai = 0; ai < 2; ++ai)
#pragma unroll
            for (int m = 0; m < 4; ++m) { const int r = row0 + ai * HALF + m * 16;
                const float* xr = (r < MP) ? xp + (size_t)r * DM : xs + (size_t)(r - MP) * DM; float s = 0.f;
#pragma unroll
                for (int bj = 0; bj < 2; ++bj)
#pragma unroll
                    for (int n = 0; n < 2; ++n) { const int c = col0 + bj * HALF + n * 16; const f32x4 v = acc[ai][bj][m][n] + __builtin_nontemporal_load((const f32x4*)(xr + c));
                        acc[ai][bj][m][n] = v; s += (v[0] * v[0] + v[1] * v[1]) + (v[2] * v[2] + v[3] * v[3]); }
                s += __shfl_xor(s, 16); s += __shfl_xor(s, 32);
                if (fq == 0) part[(ai * HALF + wr * 64 + m * 16 + fr) * 4 + wc] = s;
                if (m & 1) asm volatile("" ::: "memory"); }
        asm volatile("s_waitcnt lgkmcnt(0)" ::: "memory"); __builtin_amdgcn_s_barrier(); asm volatile("" ::: "memory");
        const int row = wid * 32 + (lane & 31);
        if (lane < 32) { const f32x4 pp = *(const LAS f32x4*)(part + row * 4);
            __hip_atomic_store(xch + (size_t)(u.pm * BM + row) * 4 + u.pn, (pp.x + pp.y) + (pp.z + pp.w), __ATOMIC_RELAXED, __HIP_MEMORY_SCOPE_AGENT); }
        asm volatile("s_waitcnt vmcnt(0)" ::: "memory");
        if (lane == 0) __hip_atomic_fetch_add(cnt + 64 * u.pm, 1u, __ATOMIC_RELAXED, __HIP_MEMORY_SCOPE_AGENT);
        if (wid == 0) {
            unsigned sp = 0;
            while ((unsigned)__builtin_amdgcn_readfirstlane(__hip_atomic_load(cnt + 64 * u.pm, __ATOMIC_RELAXED, __HIP_MEMORY_SCOPE_AGENT)) < 32u) { __builtin_amdgcn_s_sleep(2); if (++sp > (1u << 22)) break; }
            __builtin_amdgcn_fence(__ATOMIC_ACQUIRE, "agent");
        }
        asm volatile("s_waitcnt vmcnt(0) lgkmcnt(0)" ::: "memory"); __builtin_amdgcn_s_barrier(); asm volatile("" ::: "memory");
        if (lane < 32) { const float* sl = xch + (size_t)(u.pm * BM + row) * 4; float t = 0.f;
#pragma unroll
            for (int k = 0; k < 4; ++k) t += __hip_atomic_load(sl + k, __ATOMIC_RELAXED, __HIP_MEMORY_SCOPE_AGENT);
            rst[row] = 1.0f / sqrtf(t * (1.f / DM) + RMS_EPS); }
        asm volatile("s_waitcnt vmcnt(0) lgkmcnt(0)" ::: "memory"); __builtin_amdgcn_s_barrier(); asm volatile("" ::: "memory");
        f32x4 g4[2][2];
#pragma unroll
        for (int bj = 0; bj < 2; ++bj)
#pragma unroll
            for (int n = 0; n < 2; ++n) g4[bj][n] = *(const f32x4*)(fg + col0 + bj * HALF + n * 16);
#pragma unroll
        for (int ai = 0; ai < 2; ++ai)
#pragma unroll
            for (int m = 0; m < 4; ++m) { const int rl = ai * HALF + wr * 64 + m * 16 + fr; const float rs_ = rst[rl]; float* orow = out + (size_t)(u.pm * BM + rl) * DM;
#pragma unroll
                for (int bj = 0; bj < 2; ++bj)
#pragma unroll
                    for (int n = 0; n < 2; ++n) *(f32x4*)(orow + col0 + bj * HALF + n * 16) = acc[ai][bj][m][n] * rs_ * g4[bj][n]; }
        asm volatile("s_waitcnt lgkmcnt(0)" ::: "memory"); __builtin_amdgcn_s_barrier(); asm volatile("" ::: "memory");
    }
};

template <class Epi, class Sched, bool ALIGN_EPI>
__device__ __forceinline__ void gemm_phase(LAS unsigned char* lds, const Gemm g, const Sched& S, const Epi& E) {
    const int tid = threadIdx.x, wid = __builtin_amdgcn_readfirstlane(tid >> 6), lane = tid & 63, wr = wid >> 2, wc = wid & 3, fr = lane & 15, fq = lane >> 4;
    const int K = g.K, nt = K / BK, lda = g.lda;
    unsigned voffA[2], voffB[2];
#pragma unroll
    for (int i = 0; i < 2; ++i) { int R, C; stage_rc(tid * 16 + i * 8192, R, C); const int Rb = Epi::PERM ? ((R & ~31) + perm32(R & 31)) : R;
        voffA[i] = (unsigned)(R * lda + C) * 2u; voffB[i] = (unsigned)(Rb * K + C) * 2u; }
    const size_t kstep = (size_t)(BK * 2);
    const size_t hA = (size_t)HALF * lda * 2, hB = (size_t)HALF * K * 2;
    const size_t tA = 2 * hA, tB = 2 * hB;
    const unsigned ldsw = (unsigned)wid * 1024u;
    const int aoff = lds_byte(wr * 64 + fr, fq * 8), boff = lds_byte(wc * 32 + fr, fq * 8);
#define PG8_SA(b, h) (((b) * 2 + (h)) * HTB)
#define PG8_SB(b, h) ((4 + (b) * 2 + (h)) * HTB)
#define PG8_STAGE(bufoff, gbase, voff) do { _Pragma("unroll") for (int _i = 0; _i < 2; ++_i) \
        __builtin_amdgcn_global_load_lds((const unsigned*)((const char*)(gbase) + (voff)[_i]), (LAS unsigned*)(lds + (bufoff) + ldsw + _i * 8192), 16, 0, 0); } while (0)
#define PG8_LDA(dst, b, h) do { _Pragma("unroll") for (int m = 0; m < 4; ++m) _Pragma("unroll") for (int k = 0; k < 2; ++k) dst[m][k] = *(const LAS bf16x8*)(lds + PG8_SA(b, h) + aoff + m * 2048 + k * 1024); } while (0)
#define PG8_LDB(dst, b, h) do { _Pragma("unroll") for (int n = 0; n < 2; ++n) _Pragma("unroll") for (int k = 0; k < 2; ++k) dst[n][k] = *(const LAS bf16x8*)(lds + PG8_SB(b, h) + boff + n * 2048 + k * 1024); } while (0)
#define PG8_MMA(ai, bj, At, Bt) do { __builtin_amdgcn_s_setprio(1); _Pragma("unroll") for (int m = 0; m < 4; ++m) _Pragma("unroll") for (int n = 0; n < 2; ++n) _Pragma("unroll") for (int k = 0; k < 2; ++k) \
        acc[ai][bj][m][n] = __builtin_amdgcn_mfma_f32_16x16x32_bf16(Bt[n][k], At[m][k], acc[ai][bj][m][n], 0, 0, 0); __builtin_amdgcn_s_setprio(0); } while (0)
#define PG8_WAIT_V(n) asm volatile("s_waitcnt vmcnt(" #n ")" ::: "memory")
#define PG8_WAIT_L(n) asm volatile("s_waitcnt lgkmcnt(" #n ")" ::: "memory")
#define PG8_BAR __builtin_amdgcn_s_barrier()
#define PG8_SCHED __builtin_amdgcn_sched_barrier(0)
    Unit cur, nxt; int ui = 0;
    if (!S.next(0, cur)) return;
    f32x4 acc[2][2][4][2];
#pragma unroll
    for (int a = 0; a < 2; ++a)
#pragma unroll
        for (int b = 0; b < 2; ++b)
#pragma unroll
            for (int m = 0; m < 4; ++m)
#pragma unroll
                for (int n = 0; n < 2; ++n) acc[a][b][m][n] = (f32x4){0.f, 0.f, 0.f, 0.f};
    bf16x8 At[4][2], B0[2][2], B1[2][2];
    const char* cA = (const char*)g.A + (size_t)cur.pm * tA; const char* cB = (const char*)g.Bt + (size_t)cur.pn * tB;
    PG8_STAGE(PG8_SB(0, 0), cB, voffB); PG8_STAGE(PG8_SB(0, 1), cB + hB, voffB); PG8_STAGE(PG8_SA(0, 0), cA, voffA); PG8_STAGE(PG8_SA(0, 1), cA + hA, voffA);
    if (wr == 1) PG8_BAR;
    PG8_WAIT_V(2); PG8_BAR;
    PG8_STAGE(PG8_SB(1, 0), cB + kstep, voffB); PG8_STAGE(PG8_SA(1, 0), cA + kstep, voffA); PG8_STAGE(PG8_SB(1, 1), cB + hB + kstep, voffB);
    PG8_WAIT_V(6); PG8_BAR;
    for (;;) {
        const bool has_next = S.next(ui + 1, nxt);
        const char* nA = has_next ? (const char*)g.A + (size_t)nxt.pm * tA : cA; const char* nB = has_next ? (const char*)g.Bt + (size_t)nxt.pn * tB : cB;
        for (int t = 0; t < nt; t += 2) {
            const bool last = (t == nt - 2);
            const char* a1 = cA + (size_t)(t + 1) * kstep;
            const char* a2 = last ? nA : cA + (size_t)(t + 2) * kstep; const char* b2 = last ? nB : cB + (size_t)(t + 2) * kstep;
            const char* a3 = a2 + kstep; const char* b3 = b2 + kstep;
            PG8_LDB(B0, 0, 0); PG8_LDB(B1, 0, 1); PG8_SCHED; PG8_LDA(At, 0, 0); PG8_STAGE(PG8_SA(1, 1), a1 + hA, voffA);
            PG8_WAIT_V(8); PG8_WAIT_L(0); PG8_BAR; PG8_MMA(0, 0, At, B0); PG8_MMA(0, 1, At, B1); PG8_BAR; PG8_SCHED;
            PG8_LDA(At, 0, 1); PG8_STAGE(PG8_SB(0, 0), b2, voffB); PG8_STAGE(PG8_SB(0, 1), b2 + hB, voffB); PG8_STAGE(PG8_SA(0, 0), a2, voffA);
            PG8_WAIT_V(8); PG8_WAIT_L(0); PG8_BAR; PG8_MMA(1, 0, At, B0); PG8_MMA(1, 1, At, B1); PG8_BAR; PG8_SCHED;
            PG8_LDB(B0, 1, 0); PG8_LDB(B1, 1, 1); PG8_SCHED; PG8_LDA(At, 1, 0); PG8_STAGE(PG8_SA(0, 1), a2 + hA, voffA);
            PG8_WAIT_V(8); PG8_WAIT_L(0); PG8_BAR; PG8_MMA(0, 0, At, B0); PG8_MMA(0, 1, At, B1); PG8_BAR; PG8_SCHED;
            PG8_LDA(At, 1, 1); PG8_STAGE(PG8_SB(1, 0), b3, voffB); PG8_STAGE(PG8_SB(1, 1), b3 + hB, voffB); PG8_STAGE(PG8_SA(1, 0), a3, voffA);
            PG8_WAIT_V(8); PG8_WAIT_L(0); PG8_BAR; PG8_MMA(1, 0, At, B0); PG8_MMA(1, 1, At, B1); PG8_BAR; PG8_SCHED;
        }
        if constexpr (ALIGN_EPI) { if (wr == 0) PG8_BAR; }
        E(acc, cur, wr, wc, fr, fq);
        if (!has_next) break;
#pragma unroll
        for (int a = 0; a < 2; ++a)
#pragma unroll
            for (int b = 0; b < 2; ++b)
#pragma unroll
                for (int m = 0; m < 4; ++m)
#pragma unroll
                    for (int n = 0; n < 2; ++n) acc[a][b][m][n] = (f32x4){0.f, 0.f, 0.f, 0.f};
        cur = nxt; cA = nA; cB = nB; ++ui;
        if constexpr (ALIGN_EPI) { if (wr == 1) PG8_BAR; }
    }
    PG8_WAIT_V(0);
    if constexpr (!ALIGN_EPI) { if (wr == 0) PG8_BAR; }
    PG8_BAR;
#undef PG8_SA
#undef PG8_SB
#undef PG8_STAGE
#undef PG8_LDA
#undef PG8_LDB
#undef PG8_MMA
#undef PG8_WAIT_V
#undef PG8_WAIT_L
#undef PG8_BAR
#undef PG8_SCHED
}
}

struct Params {
    const float *xp, *xs, *meta, *norm_g, *w_in, *w_pool, *pool_scale, *rpb, *meta_bias, *w_out, *final_g;
    float* out; unsigned char* ws; int ph_lo, ph_hi;
};

__device__ __forceinline__ void p0_transpose_item(const float* W, int ldw, int K, bf16_t* WT, LAS float* scr, int k0, int n0, int lane, float sc) {
#pragma unroll 8
    for (int i = 0; i < 32; ++i) { const int kk = 2 * i + (lane >> 5); scr[kk * 33 + (lane & 31)] = W[(size_t)(k0 + kk) * ldw + n0 + (lane & 31)] * sc; }
    LDS_WAIT();
    const int c = lane & 7;
#pragma unroll
    for (int j = 0; j < 4; ++j) { const int n = (lane >> 3) + 8 * j; const LAS float* s = scr + (8 * c) * 33 + n;
        u32x4 o; o.x = pk2(s[0 * 33], s[1 * 33]); o.y = pk2(s[2 * 33], s[3 * 33]); o.z = pk2(s[4 * 33], s[5 * 33]); o.w = pk2(s[6 * 33], s[7 * 33]);
        *(u32x4*)(WT + (size_t)(n0 + n) * K + k0 + 8 * c) = o; }
    LDS_WAIT();
}

__device__ __forceinline__ void p0_fold_item(const Params& p, bf16_t* W1T, LAS float* scr, int item, int lane) {
    LAS float* As = scr;
    LAS float* Bs = scr + 32 * 33;
    const int kb = item & 31, db = (item >> 5) & 15, g = item >> 9, k0 = kb * 32, d0 = db * 16;
    const int k2 = lane >> 2, dq = lane & 3;
    f32x4 a0 = {0.f, 0.f, 0.f, 0.f}, a1 = {0.f, 0.f, 0.f, 0.f};
    float av[16], bv[8];
#pragma unroll
    for (int i = 0; i < 16; ++i) av[i] = p.w_in[(size_t)(k0 + 2 * i + (lane >> 5)) * NPROJ + 256 * g + (lane & 31)];
#pragma unroll
    for (int i = 0; i < 8; ++i) bv[i] = p.w_pool[(size_t)(g * 256 + 4 * i + (lane >> 4)) * 256 + d0 + (lane & 15)];
    for (int cc = 0; cc < 8; ++cc) {
#pragma unroll
        for (int i = 0; i < 16; ++i) As[(2 * i + (lane >> 5)) * 33 + (lane & 31)] = av[i];
#pragma unroll
        for (int i = 0; i < 8; ++i) Bs[(4 * i + (lane >> 4)) * 16 + (lane & 15)] = bv[i];
        if (cc < 7) {
#pragma unroll
            for (int i = 0; i < 16; ++i) av[i] = p.w_in[(size_t)(k0 + 2 * i + (lane >> 5)) * NPROJ + 256 * g + (cc + 1) * 32 + (lane & 31)];
#pragma unroll
            for (int i = 0; i < 8; ++i) bv[i] = p.w_pool[(size_t)(g * 256 + (cc + 1) * 32 + 4 * i + (lane >> 4)) * 256 + d0 + (lane & 15)];
        }
        LDS_WAIT();
#pragma unroll 8
        for (int c = 0; c < 32; ++c) { const float x0 = As[(2 * k2) * 33 + c], x1 = As[(2 * k2 + 1) * 33 + c]; const f32x4 bb = *(const LAS f32x4*)(Bs + c * 16 + 4 * dq);
            a0 += x0 * bb; a1 += x1 * bb; }
        LDS_WAIT();
    }
#pragma unroll
    for (int j = 0; j < 4; ++j) *(unsigned*)(W1T + (size_t)(256 * g + d0 + 4 * dq + j) * 1024 + k0 + 2 * k2) = pk2(a0[j], a1[j]);
}
__device__ __forceinline__ void p0_norm_row(const Params& p, bf16_t* HB, bf16_t* HM, int row, int lane) {
    const float* src = row < MP ? p.xp + (size_t)row * DM : (row < MR ? p.xs + (size_t)(row - MP) * DM : p.meta + (size_t)(row - MR) * DM);
    bf16_t* dst = row < MR ? HB + (size_t)row * DM : HM + (size_t)(row - MR) * DM;
    const f32x4* xr = (const f32x4*)src + lane; const f32x4* g4 = (const f32x4*)p.norm_g + lane;
    f32x4 v[4]; float s = 0.f;
#pragma unroll
    for (int j = 0; j < 4; ++j) { v[j] = __builtin_nontemporal_load(xr + 64 * j); s += (v[j].x * v[j].x + v[j].y * v[j].y) + (v[j].z * v[j].z + v[j].w * v[j].w); }
    const float rstd = 1.0f / sqrtf(wave_sum(s) * (1.f / DM) + RMS_EPS);
    u32x2* o8 = (u32x2*)dst + lane;
#pragma unroll
    for (int j = 0; j < 4; ++j) { const f32x4 gg = g4[64 * j]; u32x2 w; w.x = pk2(v[j].x * rstd * gg.x, v[j].y * rstd * gg.y); w.y = pk2(v[j].z * rstd * gg.z, v[j].w * rstd * gg.w); o8[64 * j] = w; }
}
__device__ __forceinline__ void p0_prologue(const Params& p, LAS unsigned char* lds, int tid, int lane, int wave) {
    bf16_t* W1T = (bf16_t*)(p.ws + WS_W1T); bf16_t* W2T = (bf16_t*)(p.ws + WS_W2T);
    bf16_t* HM = (bf16_t*)(p.ws + WS_HM); bf16_t* HB = (bf16_t*)((unsigned char*)p.out + OUT_HB);
    const int G = gridDim.x;
    LAS float* scr = (LAS float*)(lds + wave * 16384);
    const int gw = blockIdx.x * 8 + wave, NGW = G * 8;
    constexpr int IF = 2048, I1 = 16 * 160, I2 = 32 * 32;
    const int nrows = MR + NMETA, half = ((nrows / NGW) / 2) * NGW;
    if (wave & 1) for (int row = gw; row < half; row += NGW) p0_norm_row(p, HB, HM, row, lane);
    for (int it = gw; it < IF; it += NGW) p0_fold_item(p, W1T, scr, it, lane);
    for (int it = gw; it < I1 + I2; it += NGW) {
        if (it < I1) { const int kb = it / 160, nb = it % 160; const int nn = 1024 + nb * 32; p0_transpose_item(p.w_in, NPROJ, 1024, W1T, scr, kb * 64, nn, lane, (nn >= 2048 && nn < 3072) ? 0.125f * 1.4426950408889634f : 1.0f); }
        else { const int r = it - I1; const int kb = r / 32, nb = r % 32; p0_transpose_item(p.w_out, 1024, 2048, W2T, scr, kb * 64, nb * 32, lane, 1.0f); }
    }
    if (!(wave & 1)) for (int row = gw; row < half; row += NGW) p0_norm_row(p, HB, HM, row, lane);
    for (int row = half + gw; row < nrows; row += NGW) p0_norm_row(p, HB, HM, row, lane);
}

__device__ __forceinline__ void meta_proj(const Params& p, int lane, int wave) {
    const bf16_t* W1T = (const bf16_t*)(p.ws + WS_W1T); const bf16_t* HM = (const bf16_t*)(p.ws + WS_HM); float* PM = (float*)(p.ws + WS_PROJM);
    const int gw = blockIdx.x * 8 + wave, NGW = gridDim.x * 8, fr = lane & 15, fq = lane >> 4;
    for (int j = gw; j < NPROJ / 16; j += NGW) {
        const int n0 = 16 * j; f32x4 acc = {0.f, 0.f, 0.f, 0.f};
        const bf16_t* wa = W1T + (size_t)(n0 + fr) * 1024 + 8 * fq; const bf16_t* hb = HM + (size_t)fr * 1024 + 8 * fq;
#pragma unroll 4
        for (int kk = 0; kk < 32; ++kk) { const bf16x8 a = *(const bf16x8*)(wa + 32 * kk), b = *(const bf16x8*)(hb + 32 * kk);
            acc = __builtin_amdgcn_mfma_f32_16x16x32_bf16(a, b, acc, 0, 0, 0); }
        *(f32x4*)(PM + (size_t)fr * NPROJ + n0 + 4 * fq) = acc;
        if (n0 < 1024) { u32x2 w; w.x = pk2(acc[0], acc[1]); w.y = pk2(acc[2], acc[3]); *(u32x2*)((bf16_t*)(p.ws + WS_UM) + (size_t)fr * 1024 + n0 + 4 * fq) = w; }
    }
}

constexpr int AT_NS = 9;
constexpr int AT_KR = 0, AT_VR = AT_NS * 8192, AT_KM = 2 * AT_NS * 8192, AT_VM = AT_KM + 2048, AT_RPB = AT_VM + 2048, AT_END = AT_RPB + 2048;
static_assert(AT_END <= LDS_BYTES, "attention LDS map");
constexpr float LOG2E = 1.4426950408889634f;

__device__ __forceinline__ void attn_load_row(const bf16_t* P5, int seqbase, int R, int h, int tid, u32x4& kv, u32x4& vv) {
    const int col = tid >> 3, ch = tid & 7;
    const bf16_t* src = P5 + (size_t)(seqbase + R * 64 + col) * LDP5 + h * 64 + ch * 8;
    kv = __builtin_nontemporal_load((const u32x4*)(src + 2048)); vv = __builtin_nontemporal_load((const u32x4*)(src + 3072));
}
__device__ __forceinline__ void attn_write_row(LAS unsigned char* lds, int R, int tid, const u32x4 kv, const u32x4 vv) {
    const int col = tid >> 3, ch = tid & 7, slot = R % AT_NS;
    *(LAS u32x4*)(lds + AT_KR + slot * 8192 + col * 128 + ((ch ^ ((col >> 1) & 7)) << 4)) = kv;
#pragma unroll
    for (int i = 0; i < 8; ++i) { const int d = 8 * ch + i; const int sw = ((d >> 1) ^ (d >> 3)) & 7; const int pg = (col >> 2) ^ (sw << 1);
        const unsigned w = vv[i >> 1]; const unsigned short val = (unsigned short)((i & 1) ? (w >> 16) : (w & 0xffffu));
        *(LAS unsigned short*)(lds + AT_VR + slot * 8192 + d * 128 + pg * 8 + (col & 3) * 2) = val; }
}

__device__ __forceinline__ void attn_phase(const Params& p, LAS unsigned char* lds, int tid, int lane, int wave, bf16_t* OB, int ldo) {
    const bf16_t* P5 = (const bf16_t*)(p.ws + WS_P5); const float* PM = (const float*)(p.ws + WS_PROJM);
    const int fr = lane & 15, fq = lane >> 4, qg = wave & 3, rsel = wave >> 2;
    const int c0 = (qg == 0) ? 0 : (qg == 1 ? 8 : (qg == 2 ? 24 : 32));
    const int cq = 16 * qg + fr;
    const int cst = min(max(cq - 8, 0), 48);
    LAS float* rpbL = (LAS float*)(lds + AT_RPB);
    int kad[2][2], vad[4][2];
#pragma unroll
    for (int blk = 0; blk < 2; ++blk) { const int col = c0 + 16 * blk + fr, sw = (col >> 1) & 7; kad[blk][0] = col * 128 + ((fq ^ sw) << 4); kad[blk][1] = col * 128 + (((4 + fq) ^ sw) << 4); }
#pragma unroll
    for (int db = 0; db < 4; ++db) { const int d = 16 * db + fr, sw = ((d >> 1) ^ (d >> 3)) & 7, g0 = (c0 >> 2) + fq; vad[db][0] = d * 128 + ((g0 ^ (sw << 1)) << 3); vad[db][1] = d * 128 + (((g0 + 4) ^ (sw << 1)) << 3); }
    const int kmad0 = fr * 128 + ((fq ^ ((fr >> 1) & 7)) << 4), kmad1 = fr * 128 + (((4 + fq) ^ ((fr >> 1) & 7)) << 4);
    for (int run = blockIdx.x; run < 768; run += gridDim.x) {
        int s, h, rb, rows;
        if (run < 256) { s = run >> 5; const int rem = run & 31; h = rem >> 1; rb = rem & 1; rows = 32; }
        else { const int idx = run - 256; s = 8 + (idx >> 7); const int rem = idx & 127; h = rem >> 3; rb = rem & 7; rows = 128; }
        const int seqbase = s < 8 ? s * 2048 : MP + (s - 8) * 8192;
        const int r0 = rb * 16;
        __syncthreads();
        const int rs0 = min(max(r0 - 4, 0), rows - 8);
        {
            u32x4 kv[AT_NS], vv[AT_NS];
#pragma unroll
            for (int j = 0; j < AT_NS; ++j) attn_load_row(P5, seqbase, rs0 + j, h, tid, kv[j], vv[j]);
            for (int i = tid; i < 465; i += 512) rpbL[i] = p.rpb[h * 465 + i] * LOG2E;
            if (tid < 16) rpbL[480 + tid] = p.meta_bias[h * 16 + tid] * LOG2E;
            for (int i = tid; i < 1024; i += 512) { const int m = i >> 6, d = i & 63;
                const float kf = PM[(size_t)m * NPROJ + 3072 + h * 64 + d], vf = PM[(size_t)m * NPROJ + 4096 + h * 64 + d];
                *(LAS unsigned short*)(lds + AT_KM + m * 128 + (((d >> 3) ^ ((m >> 1) & 7)) << 4) + (d & 7) * 2) = (unsigned short)f2bf(kf);
                *(LAS unsigned short*)(lds + AT_VM + d * 32 + m * 2) = (unsigned short)f2bf(vf); }
#pragma unroll
            for (int j = 0; j < AT_NS; ++j) attn_write_row(lds, rs0 + j, tid, kv[j], vv[j]);
        }
        int res_hi = rs0 + AT_NS;
        u32x2 binit[8][2]; int cur_delta = -1;
        f32x4 mbinit = {0.f, 0.f, 0.f, 0.f};
        size_t tok = (size_t)(seqbase + (r0 + rsel) * 64 + cq);
        bf16x8 q0 = *(const bf16x8*)(P5 + tok * LDP5 + 1024 + h * 64 + 8 * fq), q1 = *(const bf16x8*)(P5 + tok * LDP5 + 1024 + h * 64 + 32 + 8 * fq);
        u32x2 gt[4];
#pragma unroll
        for (int db = 0; db < 4; ++db) gt[db] = *(const u32x2*)(P5 + tok * LDP5 + 4096 + h * 64 + 16 * db + 4 * fq);
        for (int ra = r0; ra < r0 + 16; ra += 2) {
            const int r = ra + rsel;
            const int rs = min(max(r - 4, 0), rows - 8);
            const bool more = (ra + 2 < r0 + 16);
            int nnewN = 0, needN = res_hi; const size_t tokN = tok + 128;
            u32x4 kaN = {0u, 0u, 0u, 0u}, vaN = kaN, kbN = kaN, vbN = kaN; bf16x8 q0N = q0, q1N = q1; u32x2 gtN[4] = {gt[0], gt[1], gt[2], gt[3]};
            if (more) {
                needN = min(max(ra + 3 - 4, 0), rows - 8) + 8; nnewN = needN - res_hi;
                if (nnewN >= 1) attn_load_row(P5, seqbase, res_hi, h, tid, kaN, vaN);
                if (nnewN >= 2) attn_load_row(P5, seqbase, res_hi + 1, h, tid, kbN, vbN);
                q0N = *(const bf16x8*)(P5 + tokN * LDP5 + 1024 + h * 64 + 8 * fq); q1N = *(const bf16x8*)(P5 + tokN * LDP5 + 1024 + h * 64 + 32 + 8 * fq);
#pragma unroll
                for (int db = 0; db < 4; ++db) gtN[db] = *(const u32x2*)(P5 + tokN * LDP5 + 4096 + h * 64 + 16 * db + 4 * fq);
            }
            __syncthreads();
            if (r - rs != cur_delta) {
                cur_delta = r - rs;
#pragma unroll
                for (int k8 = 0; k8 < 8; ++k8) { const int roff = (k8 + 7 - cur_delta) * 31;
#pragma unroll
                    for (int blk = 0; blk < 2; ++blk) { float bb[4];
#pragma unroll
                        for (int i = 0; i < 4; ++i) { const int kc = c0 + 16 * blk + 4 * fq + i; const bool ok = (unsigned)(kc - cst) < 16u; const int co = ok ? (kc - cq + 15) : 0;
                            const float b = rpbL[roff + co]; bb[i] = ok ? b : -30000.0f; }
                        binit[k8][blk].x = pg8::cvt_pk_bf16(bb[0], bb[1]); binit[k8][blk].y = pg8::cvt_pk_bf16(bb[2], bb[3]); } }
#pragma unroll
                for (int i = 0; i < 4; ++i) mbinit[i] = rpbL[480 + 4 * fq + i];
            }
            const int slot0 = rs % AT_NS;
            int sbase[8];
#pragma unroll
            for (int k8 = 0; k8 < 8; ++k8) { int slot = slot0 + k8; slot = slot >= AT_NS ? slot - AT_NS : slot; sbase[k8] = slot * 8192; }
            float mrun = -INFINITY;
            f32x4 O[4]; f32x4 L4 = {0.f, 0.f, 0.f, 0.f};
            const bf16x8 ones = {(short)0x3F80, (short)0x3F80, (short)0x3F80, (short)0x3F80, (short)0x3F80, (short)0x3F80, (short)0x3F80, (short)0x3F80};
#pragma unroll
            for (int db = 0; db < 4; ++db) O[db] = (f32x4){0.f, 0.f, 0.f, 0.f};
#pragma unroll
            for (int hf = 0; hf < 2; ++hf) {
                f32x4 S[4][2]; f32x4 Sm = mbinit;
                {
                    bf16x8 kf[2][2][2];
#define AT_RDK(buf, k8_) do { const LAS unsigned char* kbp = lds + AT_KR + sbase[k8_]; \
                    _Pragma("unroll") for (int blk = 0; blk < 2; ++blk) { kf[buf][blk][0] = *(const LAS bf16x8*)(kbp + kad[blk][0]); kf[buf][blk][1] = *(const LAS bf16x8*)(kbp + kad[blk][1]); } } while (0)
                    AT_RDK(0, 4 * hf);
#pragma unroll
                    for (int k4 = 0; k4 < 4; ++k4) {
                        if (k4 < 3) AT_RDK((k4 + 1) & 1, 4 * hf + k4 + 1);
                        __builtin_amdgcn_sched_barrier(0);
                        __builtin_amdgcn_s_setprio(1);
#pragma unroll
                        for (int blk = 0; blk < 2; ++blk) { const u32x2 bp = binit[4 * hf + k4][blk]; f32x4 a = {bflo(bp.x), bfhi(bp.x), bflo(bp.y), bfhi(bp.y)};
                            a = __builtin_amdgcn_mfma_f32_16x16x32_bf16(kf[k4 & 1][blk][0], q0, a, 0, 0, 0);
                            a = __builtin_amdgcn_mfma_f32_16x16x32_bf16(kf[k4 & 1][blk][1], q1, a, 0, 0, 0);
                            S[k4][blk] = a; }
                        __builtin_amdgcn_s_setprio(0);
                        __builtin_amdgcn_sched_barrier(0);
                    }
#undef AT_RDK
                }
                float mloc = -INFINITY;
                if (hf == 0) {
                    const bf16x8 k0 = *(const LAS bf16x8*)(lds + AT_KM + kmad0), k1 = *(const LAS bf16x8*)(lds + AT_KM + kmad1);
                    Sm = __builtin_amdgcn_mfma_f32_16x16x32_bf16(k0, q0, Sm, 0, 0, 0);
                    Sm = __builtin_amdgcn_mfma_f32_16x16x32_bf16(k1, q1, Sm, 0, 0, 0);
                    mloc = fmaxf(fmaxf(Sm[0], Sm[1]), fmaxf(Sm[2], Sm[3]));
                }
#pragma unroll
                for (int k4 = 0; k4 < 4; ++k4)
#pragma unroll
                    for (int blk = 0; blk < 2; ++blk) { const f32x4 a = S[k4][blk]; mloc = __builtin_fmaxf(__builtin_fmaxf(mloc, a[0]), a[1]); mloc = __builtin_fmaxf(__builtin_fmaxf(mloc, a[2]), a[3]); }
                mloc = fmaxf(mloc, __shfl_xor(mloc, 16)); mloc = fmaxf(mloc, __shfl_xor(mloc, 32));
                const float mx = fmaxf(mrun, mloc);
                if (hf == 1) { const float alpha = __builtin_amdgcn_exp2f(mrun - mx); L4 = L4 * alpha;
#pragma unroll
                    for (int db = 0; db < 4; ++db) O[db] = O[db] * alpha; }
                mrun = mx;
                {
                    u32x2 vf[2][4][2];
#define AT_RDV(buf, k8_) do { const LAS unsigned char* vbp = lds + AT_VR + sbase[k8_]; _Pragma("unroll") for (int db = 0; db < 4; ++db) { \
                    vf[buf][db][0] = *(const LAS u32x2*)(vbp + vad[db][0]); vf[buf][db][1] = *(const LAS u32x2*)(vbp + vad[db][1]); } } while (0)
                    AT_RDV(0, 4 * hf);
#pragma unroll
                    for (int k4 = 0; k4 < 4; ++k4) {
                        if (k4 < 3) AT_RDV((k4 + 1) & 1, 4 * hf + k4 + 1);
                        __builtin_amdgcn_sched_barrier(0);
                        float pv[8];
#pragma unroll
                        for (int blk = 0; blk < 2; ++blk)
#pragma unroll
                            for (int i = 0; i < 4; i += 2) { const f32x2 d = (f32x2){S[k4][blk][i], S[k4][blk][i + 1]} - (f32x2){mx, mx};
                                pv[blk * 4 + i] = __builtin_amdgcn_exp2f(d.x); pv[blk * 4 + i + 1] = __builtin_amdgcn_exp2f(d.y); }
                        u32x4 pw; pw.x = pg8::cvt_pk_bf16(pv[0], pv[1]); pw.y = pg8::cvt_pk_bf16(pv[2], pv[3]); pw.z = pg8::cvt_pk_bf16(pv[4], pv[5]); pw.w = pg8::cvt_pk_bf16(pv[6], pv[7]);
                        const bf16x8 pf = __builtin_bit_cast(bf16x8, pw);
                        __builtin_amdgcn_s_setprio(1);
#pragma unroll
                        for (int db = 0; db < 4; ++db) { u32x4 vw; vw.x = vf[k4 & 1][db][0].x; vw.y = vf[k4 & 1][db][0].y; vw.z = vf[k4 & 1][db][1].x; vw.w = vf[k4 & 1][db][1].y;
                            O[db] = __builtin_amdgcn_mfma_f32_16x16x32_bf16(__builtin_bit_cast(bf16x8, vw), pf, O[db], 0, 0, 0); }
                        L4 = __builtin_amdgcn_mfma_f32_16x16x32_bf16(ones, pf, L4, 0, 0, 0);
                        __builtin_amdgcn_s_setprio(0);
                        __builtin_amdgcn_sched_barrier(0);
                    }
#undef AT_RDV
                }
                if (hf == 0) {
                    float pv[4];
#pragma unroll
                    for (int i = 0; i < 4; ++i) pv[i] = __builtin_amdgcn_exp2f(Sm[i] - mx);
                    u32x4 pw; pw.x = pg8::cvt_pk_bf16(pv[0], pv[1]); pw.y = pg8::cvt_pk_bf16(pv[2], pv[3]); pw.z = 0u; pw.w = 0u;
                    const bf16x8 pf = __builtin_bit_cast(bf16x8, pw);
#pragma unroll
                    for (int db = 0; db < 4; ++db) { const int d = 16 * db + fr; const u32x2 x0 = *(const LAS u32x2*)(lds + AT_VM + d * 32 + fq * 8);
                        u32x4 vw; vw.x = x0.x; vw.y = x0.y; vw.z = 0u; vw.w = 0u;
                        O[db] = __builtin_amdgcn_mfma_f32_16x16x32_bf16(__builtin_bit_cast(bf16x8, vw), pf, O[db], 0, 0, 0); }
                    L4 = __builtin_amdgcn_mfma_f32_16x16x32_bf16(ones, pf, L4, 0, 0, 0);
                }
            }
            const float lsum = L4[0];
            __syncthreads();
            {
                const float inv = __builtin_amdgcn_rcpf(lsum);
                u32x2 wv[4];
#pragma unroll
                for (int db = 0; db < 4; ++db) { float o[4];
                    const float g0 = bflo(gt[db].x), g1 = bfhi(gt[db].x), g2 = bflo(gt[db].y), g3 = bfhi(gt[db].y);
                    o[0] = O[db][0] * inv * g0 * __builtin_amdgcn_rcpf(1.f + __expf(-g0)); o[1] = O[db][1] * inv * g1 * __builtin_amdgcn_rcpf(1.f + __expf(-g1));
                    o[2] = O[db][2] * inv * g2 * __builtin_amdgcn_rcpf(1.f + __expf(-g2)); o[3] = O[db][3] * inv * g3 * __builtin_amdgcn_rcpf(1.f + __expf(-g3));
                    wv[db].x = pg8::cvt_pk_bf16(o[0], o[1]); wv[db].y = pg8::cvt_pk_bf16(o[2], o[3]); }
#pragma unroll
                for (int pq = 0; pq < 4; pq += 2) {
                    const auto rx = __builtin_amdgcn_permlane16_swap(wv[pq].x, wv[pq + 1].x, false, false);
                    const auto ry = __builtin_amdgcn_permlane16_swap(wv[pq].y, wv[pq + 1].y, false, false);
                    u32x4 v; v.x = rx[0]; v.y = ry[0]; v.z = rx[1]; v.w = ry[1];
                    const int col = (fq & 1) ? 16 * (pq + 1) + 4 * (fq - 1) : 16 * pq + 4 * fq;
                    *(u32x4*)(OB + tok * ldo + h * 64 + col) = v; }
            }
            if (nnewN >= 1) attn_write_row(lds, res_hi, tid, kaN, vaN);
            if (nnewN >= 2) attn_write_row(lds, res_hi + 1, tid, kbN, vbN);
            if (nnewN > 0) res_hi = needN;
            q0 = q0N; q1 = q1N; tok = tokN;
#pragma unroll
            for (int db = 0; db < 4; ++db) gt[db] = gtN[db];
        }
    }
    __syncthreads();
}

template <int CH> struct PackT;
template <> struct PackT<8> { typedef u32x4 type; };
template <> struct PackT<4> { typedef u32x2 type; };
__device__ __forceinline__ void unpackv(const u32x4 w, float (&v)[8]) {
    v[0] = bflo(w.x); v[1] = bfhi(w.x); v[2] = bflo(w.y); v[3] = bfhi(w.y); v[4] = bflo(w.z); v[5] = bfhi(w.z); v[6] = bflo(w.w); v[7] = bfhi(w.w);
}
__device__ __forceinline__ void unpackv(const u32x2 w, float (&v)[4]) { v[0] = bflo(w.x); v[1] = bfhi(w.x); v[2] = bflo(w.y); v[3] = bfhi(w.y); }
__device__ __forceinline__ void packv(const float (&o)[8], u32x4& w) { w.x = pg8::cvt_pk_bf16(o[0], o[1]); w.y = pg8::cvt_pk_bf16(o[2], o[3]); w.z = pg8::cvt_pk_bf16(o[4], o[5]); w.w = pg8::cvt_pk_bf16(o[6], o[7]); }
__device__ __forceinline__ void packv(const float (&o)[4], u32x2& w) { w.x = pg8::cvt_pk_bf16(o[0], o[1]); w.y = pg8::cvt_pk_bf16(o[2], o[3]); }
template <int HALF, int TS, int CH>
__device__ __forceinline__ void pool_task(const bf16_t* U, const bf16_t* UM, const bf16_t* P5, const float* pool_scale, int seqbase, int T, int t0, int n0, bf16_t* OB, int ldo) {
    typedef typename PackT<CH>::type V;
    constexpr int NR = TS + 2 * HALF;
    asm volatile("" : "+v"(n0), "+v"(t0));
    V rows[NR];
    const bf16_t* base = U + ((long)(seqbase + t0) - HALF) * 1024 + n0;
    const bool first = (t0 == 0);
#pragma unroll
    for (int i = 0; i < NR; ++i) {
        const bf16_t* src = base + (long)i * 1024;
        if (i < HALF) src = first ? UM + (size_t)(16 - HALF + i) * 1024 + n0 : src;
        V w = *(const V*)src;
        if (i >= TS + HALF) { if (t0 - HALF + i >= T) w = V{}; }
        rows[i] = w; }
    float ps[CH];
#pragma unroll
    for (int c = 0; c < CH; c += 4) { const f32x4 a = *(const f32x4*)(pool_scale + n0 + c); ps[c] = a.x; ps[c + 1] = a.y; ps[c + 2] = a.z; ps[c + 3] = a.w; }
    float sum[CH];
#pragma unroll
    for (int i = 0; i < CH; ++i) sum[i] = 0.f;
#pragma unroll
    for (int i = 0; i < 2 * HALF; ++i) { float v[CH]; unpackv(rows[i], v);
#pragma unroll
        for (int c = 0; c < CH; ++c) sum[c] += v[c]; }
#pragma unroll
    for (int hb = 0; hb < TS / 8; ++hb) {
        V gts[8];
#pragma unroll
        for (int k = 0; k < 8; ++k) gts[k] = *(const V*)(P5 + (size_t)(seqbase + t0 + hb * 8 + k) * LDP5 + n0);
#pragma unroll
        for (int k8 = 0; k8 < 8; ++k8) { const int k = hb * 8 + k8; const int t = t0 + k;
            const int cnt = min(t + HALF, T) - (t - HALF); const float ic = __builtin_amdgcn_rcpf((float)cnt);
            float ctr[CH], add[CH], sub[CH], gv[CH]; unpackv(rows[k + HALF], ctr); unpackv(rows[k + 2 * HALF], add); unpackv(rows[k], sub); unpackv(gts[k8], gv);
            float o[CH];
#pragma unroll
            for (int c = 0; c < CH; c += 2) {
                const f32x2 gg = {gv[c], gv[c + 1]}, sm = {sum[c], sum[c + 1]}, ct = {ctr[c], ctr[c + 1]}, pp = {ps[c], ps[c + 1]};
                const f32x2 tt = gg * (-1.4426950408889634f); f32x2 den; den.x = __builtin_amdgcn_exp2f(tt.x); den.y = __builtin_amdgcn_exp2f(tt.y); den = den + 1.0f;
                f32x2 sg; sg.x = __builtin_amdgcn_rcpf(den.x); sg.y = __builtin_amdgcn_rcpf(den.y);
                const f32x2 r = (sm * ic - ct) * pp * (gg * sg);
                o[c] = r.x; o[c + 1] = r.y; sum[c] += add[c] - sub[c]; sum[c + 1] += add[c + 1] - sub[c + 1]; }
            V w; packv(o, w);
            *(V*)(OB + (size_t)(seqbase + t) * ldo + n0) = w;
            __builtin_amdgcn_sched_barrier(0); }
    }
}
__device__ __forceinline__ void pool_phase(const Params& p, int lane, int wave, bf16_t* OB, int ldo) {
    const bf16_t* U = (const bf16_t*)((const unsigned char*)p.out + OUT_U); const bf16_t* P5 = (const bf16_t*)(p.ws + WS_P5); const bf16_t* UM = (const bf16_t*)(p.ws + WS_UM);
    const int gw = blockIdx.x * 8 + wave, NGW = gridDim.x * 8;
    for (int task = gw; task < (MR / 32) * 4; task += NGW) {
        const int g = task & 3, st = task >> 2, tw = st * 32;
        int seqbase, T; if (tw < MP) { seqbase = tw & ~2047; T = 2048; } else { seqbase = MP + ((tw - MP) & ~8191); T = 8192; }
        const int t0 = tw - seqbase + (lane >> 5) * 16, n0 = g * 256 + (lane & 31) * 8;
        if (g == 0) pool_task<1, 16, 8>(U, UM, P5, p.pool_scale, seqbase, T, t0, n0, OB, ldo);
        else if (g == 1) pool_task<2, 16, 8>(U, UM, P5, p.pool_scale, seqbase, T, t0, n0, OB, ldo);
        else if (g == 2) { pool_task<4, 8, 8>(U, UM, P5, p.pool_scale, seqbase, T, t0, n0, OB, ldo); asm volatile("" ::: "memory"); pool_task<4, 8, 8>(U, UM, P5, p.pool_scale, seqbase, T, t0 + 8, n0, OB, ldo); }
        else { const int tu = tw - seqbase, n4 = 768 + lane * 4;
            pool_task<8, 16, 4>(U, UM, P5, p.pool_scale, seqbase, T, tu, n4, OB, ldo); asm volatile("" ::: "memory"); pool_task<8, 16, 4>(U, UM, P5, p.pool_scale, seqbase, T, tu + 16, n4, OB, ldo); }
    }
}

__device__ __forceinline__ void final_norm(const Params& p, int lane, int wave) {
    const float* ssq = (const float*)(p.ws + WS_SSQ); const f32x4* g4 = (const f32x4*)p.final_g + lane;
    const int gw = blockIdx.x * 8 + wave, NGW = gridDim.x * 8;
    f32x4 gg[4];
#pragma unroll
    for (int j = 0; j < 4; ++j) gg[j] = g4[64 * j];
    for (int row = gw; row < MR; row += NGW) {
        float s = lane < 16 ? ssq[(size_t)row * 16 + lane] : 0.f; s = wave_sum(s);
        const float rstd = 1.0f / sqrtf(s * (1.f / DM) + RMS_EPS);
        f32x4* o = (f32x4*)(p.out + (size_t)row * DM) + lane;
#pragma unroll
        for (int j = 0; j < 4; ++j) { const f32x4 v = o[64 * j]; o[64 * j] = v * rstd * gg[j]; }
    }
}

#define XB_TMO      128
#define XB_XCNT(j)  (256  + 64 * (j))
#define XB_XSUB(j)  (1280 + 64 * (j))
#define XB_XGEN(j)  (2304 + 64 * (j))
#define XB_TOP      3328
#define XB_TOPGEN   3392
#define XCD_BAR_WORDS 3456
#define XB_SPIN_CAP (1u << 18)

__device__ __forceinline__ unsigned xb_ld(unsigned* p)              { return __hip_atomic_load(p, __ATOMIC_RELAXED, __HIP_MEMORY_SCOPE_AGENT); }
__device__ __forceinline__ unsigned xb_add(unsigned* p, unsigned v) { return __hip_atomic_fetch_add(p, v, __ATOMIC_RELAXED, __HIP_MEMORY_SCOPE_AGENT); }
__device__ __forceinline__ unsigned xb_xcc_id() { return (unsigned)__builtin_amdgcn_s_getreg((3 << 11) | 20) & 0xFu; }
#define XB_SPIN(cond, bar) do { unsigned _sp = 0; while (cond) { __builtin_amdgcn_s_sleep(1); \
    if ((++_sp & 255u) == 0u) { if (xb_ld(&(bar)[XB_TMO])) break; if (_sp > XB_SPIN_CAP) { atomicAdd(&(bar)[XB_TMO], 1u); break; } } } } while (0)

struct XcdBarrier {
    unsigned* bar; unsigned x;
    volatile LAS unsigned* st;
};

__device__ __forceinline__ XcdBarrier xcd_barrier_post(unsigned* bar, volatile LAS unsigned* st) {
    XcdBarrier b; b.bar = bar; b.x = xb_xcc_id(); b.st = st;
    if (threadIdx.x == 0) (void)xb_add(&bar[XB_XCNT(b.x)], 1u);
    return b;
}
__device__ __forceinline__ void xcd_barrier_complete(unsigned* bar, unsigned x, unsigned& nloc, unsigned& nx) {
    const unsigned G = gridDim.x * gridDim.y * gridDim.z;
    unsigned sum, cnt, mine, sp = 0u;
    for (;;) {
        sum = 0u; cnt = 0u; mine = 0u;
#pragma unroll
        for (unsigned j = 0; j < 16; ++j) { const unsigned c = xb_ld(&bar[XB_XCNT(j)]); sum += c; cnt += (c > 0u) ? 1u : 0u; mine = (j == x) ? c : mine; }
        if (sum == G) break;
        __builtin_amdgcn_s_sleep(1);
        if ((++sp & 255u) == 0u) { if (xb_ld(&bar[XB_TMO])) break; if (sp > XB_SPIN_CAP) { atomicAdd(&bar[XB_TMO], 1u); break; } }
    }
    nloc = mine > 0u ? mine : 1u; nx = cnt > 0u ? cnt : 1u;
}

__device__ __forceinline__ void xcd_barrier(const XcdBarrier& b) {
    asm volatile("s_waitcnt vmcnt(0)" ::: "memory");
    __syncthreads();
    if (threadIdx.x == 0) {
        unsigned* bar = b.bar;
        __builtin_amdgcn_s_waitcnt(0);
        unsigned nloc = b.st[0], nx = b.st[1];
        if (nloc == 0u) { xcd_barrier_complete(bar, b.x, nloc, nx); b.st[0] = nloc; b.st[1] = nx; }
        const unsigned old = xb_add(&bar[XB_XSUB(b.x)], 1u);
        const unsigned gen = old / nloc;
        if (old + 1u == (gen + 1u) * nloc) {
            __builtin_amdgcn_fence(__ATOMIC_RELEASE, "agent");
            asm volatile("s_waitcnt vmcnt(0)" ::: "memory");
            const unsigned og = xb_add(&bar[XB_TOP], 1u);
            const unsigned tg = og / nx;
            if (og + 1u == (tg + 1u) * nx) xb_add(&bar[XB_TOPGEN], 1u);
            else XB_SPIN(xb_ld(&bar[XB_TOPGEN]) == tg, bar);
            __builtin_amdgcn_fence(__ATOMIC_ACQUIRE, "agent");
            xb_add(&bar[XB_XGEN(b.x)], 1u);
            asm volatile("s_waitcnt vmcnt(0)" ::: "memory");
        } else {
            XB_SPIN(xb_ld(&bar[XB_XGEN(b.x)]) == gen, bar);
            __builtin_amdgcn_fence(__ATOMIC_ACQUIRE, "agent");
            asm volatile("s_waitcnt vmcnt(0)" ::: "memory");
        }
    }
    __syncthreads();
}


__global__ void __launch_bounds__(512) fwd_megakernel(Params p) {
    extern __shared__ __attribute__((aligned(16))) unsigned char lds_raw[];
    LAS unsigned char* lds = (LAS unsigned char*)lds_raw;
    cg::grid_group grid = cg::this_grid();
    const int tid = threadIdx.x, lane = tid & 63, wave = __builtin_amdgcn_readfirstlane(tid >> 6);
    const int lo = p.ph_lo, hi = p.ph_hi;
#define IN(k) (lo <= (k) && (k) < hi)
    volatile LAS unsigned* bst = (volatile LAS unsigned*)(lds + LDS_BYTES - 64);
    if (tid < 2) bst[tid] = 0u;
    __syncthreads();
    XcdBarrier xbar; xbar.bar = (unsigned*)(p.ws + WS_BAR); xbar.x = 0; xbar.st = bst;
#define SEAM(k) do { if (IN(k) && IN((k) + 1)) { if ((k) == 0) grid.sync(); else xcd_barrier(xbar); } } while (0)
#if MK_N_LAUNCHES == 1
    if (blockIdx.x == 0) { unsigned* cw = (unsigned*)(p.ws + WS_CNT); for (int i = tid; i < (65536 + 16384) / 4; i += 512) cw[i] = 0u; }
#endif
#ifndef PROBE_DUP
#define PROBE_DUP 0
#endif
    if (IN(0)) { p0_prologue(p, lds, tid, lane, wave); if (PROBE_DUP == 5) p0_prologue(p, lds, tid, lane, wave); }
    SEAM(0);
    if (IN(0) && IN(1)) xbar = xcd_barrier_post((unsigned*)(p.ws + WS_BAR), bst);
    if (IN(1)) {
        meta_proj(p, lane, wave);
        pg8::Gemm g{(const bf16_t*)((const unsigned char*)p.out + OUT_HB), (const bf16_t*)(p.ws + WS_W1T), MR, NPROJ, 1024, 1024};
        pg8::StaticOrder S; S.init(MR, NPROJ, gridDim.x, blockIdx.x);
        pg8::EpiProj E{(bf16_t*)((unsigned char*)p.out + OUT_U), (bf16_t*)(p.ws + WS_P5)};
        pg8::gemm_phase<pg8::EpiProj, pg8::StaticOrder, true>(lds, g, S, E);
        if (PROBE_DUP == 1) pg8::gemm_phase<pg8::EpiProj, pg8::StaticOrder, true>(lds, g, S, E);
    }
    SEAM(1);
    if (IN(2)) {
        bf16_t* P5o = (bf16_t*)(p.ws + WS_P5); bf16_t* SCR = (bf16_t*)((unsigned char*)p.out + OUT_HB);
        if (PROBE_DUP == 2) attn_phase(p, lds, tid, lane, wave, SCR, 1024);
        if (PROBE_DUP == 3) pool_phase(p, lane, wave, SCR, 1024);
        if (blockIdx.x & 1) pool_phase(p, lane, wave, P5o, LDP5);
        attn_phase(p, lds, tid, lane, wave, P5o + 1024, LDP5);
        if (!(blockIdx.x & 1)) pool_phase(p, lane, wave, P5o, LDP5);
    }
    SEAM(2);
    if (IN(3)) {
        pg8::Gemm g{(const bf16_t*)(p.ws + WS_P5), (const bf16_t*)(p.ws + WS_W2T), MR, 1024, 2048, LDP5};
#if FUSE_NORM
        pg8::PanelOrder S; S.init(MR, 1024, gridDim.x, blockIdx.x);
        pg8::EpiOutN E{p.xp, p.xs, p.out, (float*)(p.ws + WS_SSQ), (unsigned*)(p.ws + WS_CNT), p.final_g, lds + 131072};
        pg8::gemm_phase<pg8::EpiOutN, pg8::PanelOrder, true>(lds, g, S, E);
#else
        pg8::StaticOrder S; S.init(MR, 1024, gridDim.x, blockIdx.x);
        pg8::EpiOut E{p.xp, p.xs, p.out, (float*)(p.ws + WS_SSQ)};
        pg8::gemm_phase<pg8::EpiOut, pg8::StaticOrder, true>(lds, g, S, E);
        if (PROBE_DUP == 4) pg8::gemm_phase<pg8::EpiOut, pg8::StaticOrder, true>(lds, g, S, E);
#endif
    }
#if !FUSE_NORM
    SEAM(3);
    if (IN(4)) { final_norm(p, lane, wave); }
#endif
#undef IN
#undef SEAM
}

extern "C" void kernel_launch(void* const* d_in, const int* in_sizes, int n_in, void* d_out, int out_size, void* d_ws, size_t ws_size, hipStream_t stream) {
    static int grid = 0;
    if (grid == 0) {
        if (n_in != 11 || out_size != MR * DM || ws_size < WS_END) { fprintf(stderr, "kernel_launch: unexpected shapes: n_in %d out %d ws %zu (need %zu)\n", n_in, out_size, ws_size, (size_t)WS_END); grid = -1; return; }
        int dev = 0, cus = 0, per_cu = 0;
        if (hipGetDevice(&dev) != hipSuccess || hipDeviceGetAttribute(&cus, hipDeviceAttributeMultiprocessorCount, dev) != hipSuccess) { grid = -1; return; }
        if (hipFuncSetAttribute((const void*)fwd_megakernel, hipFuncAttributeMaxDynamicSharedMemorySize, LDS_BYTES) != hipSuccess) { fprintf(stderr, "kernel_launch: hipFuncSetAttribute failed\n"); grid = -1; return; }
        if (hipOccupancyMaxActiveBlocksPerMultiprocessor(&per_cu, (const void*)fwd_megakernel, 512, LDS_BYTES) != hipSuccess || per_cu < 1) { fprintf(stderr, "kernel_launch: occupancy query failed (%d)\n", per_cu); grid = -1; return; }
        grid = cus * per_cu;
    }
    if (grid < 0) return;
    Params p{};
    p.xp = (const float*)d_in[0]; p.xs = (const float*)d_in[1]; p.meta = (const float*)d_in[2]; p.norm_g = (const float*)d_in[3]; p.w_in = (const float*)d_in[4];
    p.w_pool = (const float*)d_in[5]; p.pool_scale = (const float*)d_in[6]; p.rpb = (const float*)d_in[7]; p.meta_bias = (const float*)d_in[8]; p.w_out = (const float*)d_in[9];
    p.final_g = (const float*)d_in[10]; p.out = (float*)d_out; p.ws = (unsigned char*)d_ws;
#if FUSE_NORM && MK_N_LAUNCHES != 1
    if (hipMemsetAsync((char*)d_ws + WS_CNT, 0, 65536 + 16384, stream) != hipSuccess) { fprintf(stderr, "kernel_launch: memset failed\n"); return; }
#endif
#if MK_N_LAUNCHES == 1
    p.ph_lo = 0; p.ph_hi = 5;
    void* args[] = {&p};
    hipError_t e = hipLaunchCooperativeKernel((const void*)fwd_megakernel, dim3(grid), dim3(512), args, LDS_BYTES, stream);
    if (e != hipSuccess) fprintf(stderr, "kernel_launch: cooperative launch failed: %s (grid %d)\n", hipGetErrorString(e), grid);
#else
    for (int i = 0; i < 5; ++i) { p.ph_lo = i; p.ph_hi = i + 1; hipLaunchKernelGGL(fwd_megakernel, dim3(grid), dim3(512), LDS_BYTES, stream, p); }
#endif
}
```

```cpp
#include <hip/hip_runtime.h>
#include <hip/hip_cooperative_groups.h>
#include <cstdio>
#include <cstdint>
namespace cg = cooperative_groups;

#ifndef MK_N_LAUNCHES
#define MK_N_LAUNCHES 1
#endif
#ifndef FUSE_NORM
#define FUSE_NORM 1
#endif

#define LAS __attribute__((address_space(3)))
typedef unsigned short bf16_t;
typedef short bf16x8 __attribute__((ext_vector_type(8)));
typedef float f32x4 __attribute__((ext_vector_type(4)));
typedef float f32x2 __attribute__((ext_vector_type(2)));
typedef unsigned u32x4 __attribute__((ext_vector_type(4)));
typedef unsigned u32x2 __attribute__((ext_vector_type(2)));

constexpr int DM = 1024;
constexpr int MR = 49152;
constexpr int MP = 16384;
constexpr int NPROJ = 6144;
constexpr int LDP5 = 5120;
constexpr int NMETA = 16;
constexpr float RMS_EPS = 1e-6f;

constexpr size_t MiB = 1u << 20;
constexpr size_t WS_W1T = 0;
constexpr size_t WS_W2T = 12 * MiB;
constexpr size_t WS_HM = 16 * MiB;
constexpr size_t WS_UM = 16 * MiB + 32768;
constexpr size_t WS_PROJM = 16 * MiB + 65536;
constexpr size_t WS_SSQ = 17 * MiB;
constexpr size_t WS_CNT = 19 * MiB;
constexpr size_t WS_BAR = 19 * MiB + 65536;
constexpr size_t WS_P5 = 20 * MiB;
constexpr size_t WS_END = WS_P5 + (size_t)MR * LDP5 * 2;
constexpr size_t OUT_U = 0, OUT_HB = (size_t)MR * 1024 * 2;

constexpr int LDS_BYTES = 160 * 1024;

__device__ __forceinline__ unsigned f2bf(float f) { unsigned u = __builtin_bit_cast(unsigned, f); return (u + 0x7fffu + ((u >> 16) & 1u)) >> 16; }
typedef __bf16 bf16x2_t __attribute__((ext_vector_type(2)));
__device__ __forceinline__ unsigned pk2(float lo, float hi) { const f32x2 v = {lo, hi}; return __builtin_bit_cast(unsigned, __builtin_convertvector(v, bf16x2_t)); }
__device__ __forceinline__ float bflo(unsigned w) { return __builtin_bit_cast(float, w << 16); }
__device__ __forceinline__ float bfhi(unsigned w) { return __builtin_bit_cast(float, w & 0xffff0000u); }
__device__ __forceinline__ float wave_sum(float v) {
#pragma unroll
    for (int o = 1; o < 64; o <<= 1) v += __shfl_xor(v, o);
    return v;
}
__device__ __forceinline__ float xred_max(float x) {
    const unsigned u = __builtin_bit_cast(unsigned, x); const auto r = __builtin_amdgcn_permlane16_swap(u, u, false, false);
    const float a = __builtin_fmaxf(__builtin_bit_cast(float, (unsigned)r[0]), __builtin_bit_cast(float, (unsigned)r[1]));
    const unsigned v = __builtin_bit_cast(unsigned, a); const auto q = __builtin_amdgcn_permlane32_swap(v, v, false, false);
    return __builtin_fmaxf(__builtin_bit_cast(float, (unsigned)q[0]), __builtin_bit_cast(float, (unsigned)q[1]));
}
__device__ __forceinline__ float xred_sum(float x) {
    const unsigned u = __builtin_bit_cast(unsigned, x); const auto r = __builtin_amdgcn_permlane16_swap(u, u, false, false);
    const float a = __builtin_bit_cast(float, (unsigned)r[0]) + __builtin_bit_cast(float, (unsigned)r[1]);
    const unsigned v = __builtin_bit_cast(unsigned, a); const auto q = __builtin_amdgcn_permlane32_swap(v, v, false, false);
    return __builtin_bit_cast(float, (unsigned)q[0]) + __builtin_bit_cast(float, (unsigned)q[1]);
}
#define LDS_WAIT() asm volatile("s_waitcnt lgkmcnt(0)" ::: "memory")

namespace pg8 {
constexpr int BM = 256, BK = 64, HALF = 128, HTB = HALF * BK * 2, STAGE_BYTES = 8 * HTB, NXCD = 8, WGM = 8;
__host__ __device__ __forceinline__ int lds_byte(int r, int c) { const int st = (r >> 4) * 2 + (c >> 5), rr = r & 15, cc = c & 31, ob = rr * 64 + cc * 2; return st * 1024 + (ob ^ (((ob >> 9) & 1) << 5)); }
__host__ __device__ __forceinline__ void stage_rc(int b, int& R, int& C) { const int st = b / 1024, sb = b % 1024, swz = sb ^ (((sb >> 9) & 1) << 5); R = (st >> 1) * 16 + swz / 64; C = (st & 1) * 32 + (swz % 64) / 2; }
__host__ __device__ __forceinline__ int perm32(int rho) { const int n = rho >> 4, i = rho & 15; return 8 * (i >> 2) + 4 * n + (i & 3); }

struct Unit { int pm, pn; };
struct Gemm { const bf16_t* A; const bf16_t* Bt; int M, N, K, lda; };

struct StaticOrder {
    int nM, nN, nwg, G, c;
    __host__ __device__ void init(int M, int N, int G_, int c_) { nM = M / BM; nN = N / BM; nwg = nM * nN; G = G_; c = c_; }
    __host__ __device__ bool next(int i, Unit& u) const {
        const long L = (long)i * G + c; if (L >= nwg) return false;
        int wgid = (int)L; { const int q = nwg / NXCD, r = nwg % NXCD, xcd = wgid % NXCD, off = wgid / NXCD; wgid = (xcd < r ? xcd * (q + 1) : r * (q + 1) + (xcd - r) * q) + off; }
        const int nig = WGM * nN, gid = wgid / nig, fm = gid * WGM, gsz = (nM - fm) < WGM ? (nM - fm) : WGM;
        u.pm = fm + ((wgid % nig) % gsz); u.pn = (wgid % nig) / gsz; return true;
    }
};

__device__ __forceinline__ unsigned cvt_pk_bf16(float lo, float hi) { const f32x2 v = {lo, hi}; return __builtin_bit_cast(unsigned, __builtin_convertvector(v, bf16x2_t)); }

struct EpiProj {
    static constexpr bool PERM = true;
    bf16_t* U; bf16_t* P5;
    __device__ __forceinline__ void operator()(const f32x4 (&acc)[2][2][4][2], const Unit& u, int wr, int wc, int fr, int fq) const {
        const int row0 = u.pm * BM + wr * 64 + fr;
        bf16_t* base; int ldc, colt;
        if (u.pn < 4) { base = U; ldc = 1024; colt = u.pn * BM; } else { base = P5; ldc = LDP5; colt = u.pn * BM - 1024; }
        const int col0 = colt + wc * 32 + 8 * fq;
#pragma unroll
        for (int ai = 0; ai < 2; ++ai)
#pragma unroll
            for (int m = 0; m < 4; ++m) { bf16_t* rowp = base + (size_t)(row0 + ai * HALF + m * 16) * ldc + col0;
#pragma unroll
                for (int bj = 0; bj < 2; ++bj) { const f32x4 v0 = acc[ai][bj][m][0], v1 = acc[ai][bj][m][1];
                    u32x4 w; w.x = cvt_pk_bf16(v0[0], v0[1]); w.y = cvt_pk_bf16(v0[2], v0[3]); w.z = cvt_pk_bf16(v1[0], v1[1]); w.w = cvt_pk_bf16(v1[2], v1[3]);
                    *(u32x4*)(rowp + bj * HALF) = w; } }
    }
};
struct EpiOut {
    static constexpr bool PERM = false;
    const float* xp; const float* xs; float* out; float* ssq;
    __device__ __forceinline__ void operator()(const f32x4 (&acc)[2][2][4][2], const Unit& u, int wr, int wc, int fr, int fq) const {
        const int row0 = u.pm * BM + wr * 64 + fr, col0 = u.pn * BM + wc * 32 + 4 * fq;
#pragma unroll
        for (int ai = 0; ai < 2; ++ai)
#pragma unroll
            for (int m = 0; m < 4; ++m) { const int r = row0 + ai * HALF + m * 16;
                const float* xr = (r < MP) ? xp + (size_t)r * DM : xs + (size_t)(r - MP) * DM; float* orow = out + (size_t)r * DM; float s = 0.f;
#pragma unroll
                for (int bj = 0; bj < 2; ++bj)
#pragma unroll
                    for (int n = 0; n < 2; ++n) { const int c = col0 + bj * HALF + n * 16; const f32x4 v = acc[ai][bj][m][n] + *(const f32x4*)(xr + c);
                        *(f32x4*)(orow + c) = v; s += (v[0] * v[0] + v[1] * v[1]) + (v[2] * v[2] + v[3] * v[3]); }
                s += __shfl_xor(s, 16); s += __shfl_xor(s, 32);
                if (fq == 0) ssq[(size_t)r * 16 + u.pn * 4 + wc] = s;
                if (m & 1) asm volatile("" ::: "memory"); }
    }
};

struct PanelOrder {
    int nwg, G, c;
    __host__ __device__ void init(int M, int N, int G_, int bx) { nwg = (M / BM) * (N / BM); G = G_; c = (G_ % 8 == 0) ? (bx % 8) * (G_ / 8) + bx / 8 : bx; }
    __host__ __device__ bool next(int i, Unit& u) const { const long L = (long)i * G + c; if (L >= nwg) return false; u.pm = (int)(L >> 2); u.pn = (int)(L & 3); return true; }
};
struct EpiOutN {
    static constexpr bool PERM = false;
    const float* xp; const float* xs; float* out; float* xch; unsigned* cnt; const float* fg; LAS unsigned char* lx;
    __device__ __forceinline__ void operator()(f32x4 (&acc)[2][2][4][2], const Unit& u, int wr, int wc, int fr, int fq) const {
        const int tid = threadIdx.x, lane = tid & 63, wid = tid >> 6;
        LAS float* part = (LAS float*)lx;
        LAS float* rst = (LAS float*)(lx + 4096);
        const int row0 = u.pm * BM + wr * 64 + fr, col0 = u.pn * BM + wc * 32 + 4 * fq;
#pragma unroll
        for (int ai = 0; ai < 2; ++ai)
#pragma unroll
            for (int m = 0; m < 4; ++m) { const int r = row0 + ai * HALF + m * 16;
                const float* xr = (r < MP) ? xp + (size_t)r * DM : xs + (size_t)(r - MP) * DM; float s = 0.f;
#pragma unroll
                for (int bj = 0; bj < 2; ++bj)
#pragma unroll
                    for (int n = 0; n < 2; ++n) { const int c = col0 + bj * HALF + n * 16; const f32x4 v = acc[ai][bj][m][n] + __builtin_nontemporal_load((const f32x4*)(xr + c));
                        acc[ai][bj][m][n] = v; s += (v[0] * v[0] + v[1] * v[1]) + (v[2] * v[2] + v[3] * v[3]); }
                s = xred_sum(s);
                if (fq == 0) part[(ai * HALF + wr * 64 + m * 16 + fr) * 4 + wc] = s;
                if (m & 1) asm volatile("" ::: "memory"); }
        asm volatile("s_waitcnt lgkmcnt(0)" ::: "memory"); __builtin_amdgcn_s_barrier(); asm volatile("" ::: "memory");
        const int row = wid * 32 + (lane & 31);
        if (lane < 32) { const f32x4 pp = *(const LAS f32x4*)(part + row * 4);
            __hip_atomic_store(xch + (size_t)(u.pm * BM + row) * 4 + u.pn, (pp.x + pp.y) + (pp.z + pp.w), __ATOMIC_RELAXED, __HIP_MEMORY_SCOPE_AGENT); }
        asm volatile("s_waitcnt vmcnt(0)" ::: "memory");
        if (lane == 0) __hip_atomic_fetch_add(cnt + 64 * u.pm, 1u, __ATOMIC_RELAXED, __HIP_MEMORY_SCOPE_AGENT);
        if (wid == 0) {
            unsigned sp = 0;
            while ((unsigned)__builtin_amdgcn_readfirstlane(__hip_atomic_load(cnt + 64 * u.pm, __ATOMIC_RELAXED, __HIP_MEMORY_SCOPE_AGENT)) < 32u) { __builtin_amdgcn_s_sleep(2); if (++sp > (1u << 22)) break; }
            __builtin_amdgcn_fence(__ATOMIC_ACQUIRE, "agent");
        }
        asm volatile("s_waitcnt vmcnt(0) lgkmcnt(0)" ::: "memory"); __builtin_amdgcn_s_barrier(); asm volatile("" ::: "memory");
        if (lane < 32) { const float* sl = xch + (size_t)(u.pm * BM + row) * 4; float t = 0.f;
#pragma unroll
            for (int k = 0; k < 4; ++k) t += __hip_atomic_load(sl + k, __ATOMIC_RELAXED, __HIP_MEMORY_SCOPE_AGENT);
            rst[row] = 1.0f / sqrtf(t * (1.f / DM) + RMS_EPS); }
        asm volatile("s_waitcnt vmcnt(0) lgkmcnt(0)" ::: "memory"); __builtin_amdgcn_s_barrier(); asm volatile("" ::: "memory");
        f32x4 g4[2][2];
#pragma unroll
        for (int bj = 0; bj < 2; ++bj)
#pragma unroll
            for (int n = 0; n < 2; ++n) g4[bj][n] = *(const f32x4*)(fg + col0 + bj * HALF + n * 16);
#pragma unroll
        for (int ai = 0; ai < 2; ++ai)
#pragma unroll
            for (int m = 0; m < 4; ++m) { const int rl = ai * HALF + wr * 64 + m * 16 + fr; const float rs_ = rst[rl]; float* orow = out + (size_t)(u.pm * BM + rl) * DM;
#pragma unroll
                for (int bj = 0; bj < 2; ++bj)
#pragma unroll
                    for (int n = 0; n < 2; ++n) *(f32x4*)(orow + col0 + bj * HALF + n * 16) = acc[ai][bj][m][n] * rs_ * g4[bj][n]; }
        asm volatile("s_waitcnt lgkmcnt(0)" ::: "memory"); __builtin_amdgcn_s_barrier(); asm volatile("" ::: "memory");
    }
};

template <class Epi, class Sched, bool ALIGN_EPI>
__device__ __forceinline__ void gemm_phase(LAS unsigned char* lds, const Gemm g, const Sched& S, const Epi& E) {
    const int tid = threadIdx.x, wid = __builtin_amdgcn_readfirstlane(tid >> 6), lane = tid & 63, wr = wid >> 2, wc = wid & 3, fr = lane & 15, fq = lane >> 4;
    const int K = g.K, nt = K / BK, lda = g.lda;
    unsigned voffA[2], voffB[2];
#pragma unroll
    for (int i = 0; i < 2; ++i) { int R, C; stage_rc(tid * 16 + i * 8192, R, C); const int Rb = Epi::PERM ? ((R & ~31) + perm32(R & 31)) : R;
        voffA[i] = (unsigned)(R * lda + C) * 2u; voffB[i] = (unsigned)(Rb * K + C) * 2u; }
    const size_t kstep = (size_t)(BK * 2);
    const size_t hA = (size_t)HALF * lda * 2, hB = (size_t)HALF * K * 2;
    const size_t tA = 2 * hA, tB = 2 * hB;
    const unsigned ldsw = (unsigned)wid * 1024u;
    const int aoff = lds_byte(wr * 64 + fr, fq * 8), boff = lds_byte(wc * 32 + fr, fq * 8);
#define PG8_SA(b, h) (((b) * 2 + (h)) * HTB)
#define PG8_SB(b, h) ((4 + (b) * 2 + (h)) * HTB)
#define PG8_STAGE(bufoff, gbase, voff) do { _Pragma("unroll") for (int _i = 0; _i < 2; ++_i) \
        __builtin_amdgcn_global_load_lds((const unsigned*)((const char*)(gbase) + (voff)[_i]), (LAS unsigned*)(lds + (bufoff) + ldsw + _i * 8192), 16, 0, 0); } while (0)
#define PG8_LDA(dst, b, h) do { _Pragma("unroll") for (int m = 0; m < 4; ++m) _Pragma("unroll") for (int k = 0; k < 2; ++k) dst[m][k] = *(const LAS bf16x8*)(lds + PG8_SA(b, h) + aoff + m * 2048 + k * 1024); } while (0)
#define PG8_LDB(dst, b, h) do { _Pragma("unroll") for (int n = 0; n < 2; ++n) _Pragma("unroll") for (int k = 0; k < 2; ++k) dst[n][k] = *(const LAS bf16x8*)(lds + PG8_SB(b, h) + boff + n * 2048 + k * 1024); } while (0)
#define PG8_MMA(ai, bj, At, Bt) do { __builtin_amdgcn_s_setprio(1); _Pragma("unroll") for (int m = 0; m < 4; ++m) _Pragma("unroll") for (int n = 0; n < 2; ++n) _Pragma("unroll") for (int k = 0; k < 2; ++k) \
        acc[ai][bj][m][n] = __builtin_amdgcn_mfma_f32_16x16x32_bf16(Bt[n][k], At[m][k], acc[ai][bj][m][n], 0, 0, 0); __builtin_amdgcn_s_setprio(0); } while (0)
#define PG8_WAIT_V(n) asm volatile("s_waitcnt vmcnt(" #n ")" ::: "memory")
#define PG8_WAIT_L(n) asm volatile("s_waitcnt lgkmcnt(" #n ")" ::: "memory")
#define PG8_BAR __builtin_amdgcn_s_barrier()
#define PG8_SCHED __builtin_amdgcn_sched_barrier(0)
    Unit cur, nxt; int ui = 0;
    if (!S.next(0, cur)) return;
    f32x4 acc[2][2][4][2];
#pragma unroll
    for (int a = 0; a < 2; ++a)
#pragma unroll
        for (int b = 0; b < 2; ++b)
#pragma unroll
            for (int m = 0; m < 4; ++m)
#pragma unroll
                for (int n = 0; n < 2; ++n) acc[a][b][m][n] = (f32x4){0.f, 0.f, 0.f, 0.f};
    bf16x8 At[4][2], B0[2][2], B1[2][2];
    const char* cA = (const char*)g.A + (size_t)cur.pm * tA; const char* cB = (const char*)g.Bt + (size_t)cur.pn * tB;
    PG8_STAGE(PG8_SB(0, 0), cB, voffB); PG8_STAGE(PG8_SB(0, 1), cB + hB, voffB); PG8_STAGE(PG8_SA(0, 0), cA, voffA); PG8_STAGE(PG8_SA(0, 1), cA + hA, voffA);
    if (wr == 1) PG8_BAR;
    PG8_WAIT_V(2); PG8_BAR;
    PG8_STAGE(PG8_SB(1, 0), cB + kstep, voffB); PG8_STAGE(PG8_SA(1, 0), cA + kstep, voffA); PG8_STAGE(PG8_SB(1, 1), cB + hB + kstep, voffB);
    PG8_WAIT_V(6); PG8_BAR;
    for (;;) {
        const bool has_next = S.next(ui + 1, nxt);
        const char* nA = has_next ? (const char*)g.A + (size_t)nxt.pm * tA : cA; const char* nB = has_next ? (const char*)g.Bt + (size_t)nxt.pn * tB : cB;
        for (int t = 0; t < nt; t += 2) {
            const bool last = (t == nt - 2);
            const char* a1 = cA + (size_t)(t + 1) * kstep;
            const char* a2 = last ? nA : cA + (size_t)(t + 2) * kstep; const char* b2 = last ? nB : cB + (size_t)(t + 2) * kstep;
            const char* a3 = a2 + kstep; const char* b3 = b2 + kstep;
            PG8_LDB(B0, 0, 0); PG8_LDB(B1, 0, 1); PG8_SCHED; PG8_LDA(At, 0, 0); PG8_STAGE(PG8_SA(1, 1), a1 + hA, voffA);
            PG8_WAIT_V(8); PG8_WAIT_L(0); PG8_BAR; PG8_MMA(0, 0, At, B0); PG8_MMA(0, 1, At, B1); PG8_BAR; PG8_SCHED;
            PG8_LDA(At, 0, 1); PG8_STAGE(PG8_SB(0, 0), b2, voffB); PG8_STAGE(PG8_SB(0, 1), b2 + hB, voffB); PG8_STAGE(PG8_SA(0, 0), a2, voffA);
            PG8_WAIT_V(8); PG8_WAIT_L(0); PG8_BAR; PG8_MMA(1, 0, At, B0); PG8_MMA(1, 1, At, B1); PG8_BAR; PG8_SCHED;
            PG8_LDB(B0, 1, 0); PG8_LDB(B1, 1, 1); PG8_SCHED; PG8_LDA(At, 1, 0); PG8_STAGE(PG8_SA(0, 1), a2 + hA, voffA);
            PG8_WAIT_V(8); PG8_WAIT_L(0); PG8_BAR; PG8_MMA(0, 0, At, B0); PG8_MMA(0, 1, At, B1); PG8_BAR; PG8_SCHED;
            PG8_LDA(At, 1, 1); PG8_STAGE(PG8_SB(1, 0), b3, voffB); PG8_STAGE(PG8_SB(1, 1), b3 + hB, voffB); PG8_STAGE(PG8_SA(1, 0), a3, voffA);
            PG8_WAIT_V(8); PG8_WAIT_L(0); PG8_BAR; PG8_MMA(1, 0, At, B0); PG8_MMA(1, 1, At, B1); PG8_BAR; PG8_SCHED;
        }
        if constexpr (ALIGN_EPI) { if (wr == 0) PG8_BAR; }
        E(acc, cur, wr, wc, fr, fq);
        if (!has_next) break;
#pragma unroll
        for (int a = 0; a < 2; ++a)
#pragma unroll
            for (int b = 0; b < 2; ++b)
#pragma unroll
                for (int m = 0; m < 4; ++m)
#pragma unroll
                    for (int n = 0; n < 2; ++n) acc[a][b][m][n] = (f32x4){0.f, 0.f, 0.f, 0.f};
        cur = nxt; cA = nA; cB = nB; ++ui;
        if constexpr (ALIGN_EPI) { if (wr == 1) PG8_BAR; }
    }
    PG8_WAIT_V(0);
    if constexpr (!ALIGN_EPI) { if (wr == 0) PG8_BAR; }
    PG8_BAR;
#undef PG8_SA
#undef PG8_SB
#undef PG8_STAGE
#undef PG8_LDA
#undef PG8_LDB
#undef PG8_MMA
#undef PG8_WAIT_V
#undef PG8_WAIT_L
#undef PG8_BAR
#undef PG8_SCHED
}
}

struct Params {
    const float *xp, *xs, *meta, *norm_g, *w_in, *w_pool, *pool_scale, *rpb, *meta_bias, *w_out, *final_g;
    float* out; unsigned char* ws; int ph_lo, ph_hi;
};

__device__ __forceinline__ void p0_transpose_item(const float* W, int ldw, int K, bf16_t* WT, LAS float* scr, int k0, int n0, int lane, float sc) {
#pragma unroll 8
    for (int i = 0; i < 32; ++i) { const int kk = 2 * i + (lane >> 5); scr[kk * 33 + (lane & 31)] = W[(size_t)(k0 + kk) * ldw + n0 + (lane & 31)] * sc; }
    LDS_WAIT();
    const int c = lane & 7;
#pragma unroll
    for (int j = 0; j < 4; ++j) { const int n = (lane >> 3) + 8 * j; const LAS float* s = scr + (8 * c) * 33 + n;
        u32x4 o; o.x = pk2(s[0 * 33], s[1 * 33]); o.y = pk2(s[2 * 33], s[3 * 33]); o.z = pk2(s[4 * 33], s[5 * 33]); o.w = pk2(s[6 * 33], s[7 * 33]);
        *(u32x4*)(WT + (size_t)(n0 + n) * K + k0 + 8 * c) = o; }
    LDS_WAIT();
}

__device__ __forceinline__ void p0_fold_item(const Params& p, bf16_t* W1T, LAS float* scr, int item, int lane) {
    LAS float* As = scr;
    LAS float* Bs = scr + 32 * 33;
    const int kb = item & 31, db = (item >> 5) & 15, g = item >> 9, k0 = kb * 32, d0 = db * 16;
    const int k2 = lane >> 2, dq = lane & 3;
    f32x4 a0 = {0.f, 0.f, 0.f, 0.f}, a1 = {0.f, 0.f, 0.f, 0.f};
    float av[16], bv[8];
#pragma unroll
    for (int i = 0; i < 16; ++i) av[i] = p.w_in[(size_t)(k0 + 2 * i + (lane >> 5)) * NPROJ + 256 * g + (lane & 31)];
#pragma unroll
    for (int i = 0; i < 8; ++i) bv[i] = p.w_pool[(size_t)(g * 256 + 4 * i + (lane >> 4)) * 256 + d0 + (lane & 15)];
    for (int cc = 0; cc < 8; ++cc) {
#pragma unroll
        for (int i = 0; i < 16; ++i) As[(2 * i + (lane >> 5)) * 33 + (lane & 31)] = av[i];
#pragma unroll
        for (int i = 0; i < 8; ++i) Bs[(4 * i + (lane >> 4)) * 16 + (lane & 15)] = bv[i];
        if (cc < 7) {
#pragma unroll
            for (int i = 0; i < 16; ++i) av[i] = p.w_in[(size_t)(k0 + 2 * i + (lane >> 5)) * NPROJ + 256 * g + (cc + 1) * 32 + (lane & 31)];
#pragma unroll
            for (int i = 0; i < 8; ++i) bv[i] = p.w_pool[(size_t)(g * 256 + (cc + 1) * 32 + 4 * i + (lane >> 4)) * 256 + d0 + (lane & 15)];
        }
        LDS_WAIT();
#pragma unroll 8
        for (int c = 0; c < 32; ++c) { const float x0 = As[(2 * k2) * 33 + c], x1 = As[(2 * k2 + 1) * 33 + c]; const f32x4 bb = *(const LAS f32x4*)(Bs + c * 16 + 4 * dq);
            a0 += x0 * bb; a1 += x1 * bb; }
        LDS_WAIT();
    }
#pragma unroll
    for (int j = 0; j < 4; ++j) *(unsigned*)(W1T + (size_t)(256 * g + d0 + 4 * dq + j) * 1024 + k0 + 2 * k2) = pk2(a0[j], a1[j]);
}
__device__ __forceinline__ void p0_norm_row(const Params& p, bf16_t* HB, bf16_t* HM, int row, int lane) {
    const float* src = row < MP ? p.xp + (size_t)row * DM : (row < MR ? p.xs + (size_t)(row - MP) * DM : p.meta + (size_t)(row - MR) * DM);
    bf16_t* dst = row < MR ? HB + (size_t)row * DM : HM + (size_t)(row - MR) * DM;
    const f32x4* xr = (const f32x4*)src + lane; const f32x4* g4 = (const f32x4*)p.norm_g + lane;
    f32x4 v[4]; float s = 0.f;
#pragma unroll
    for (int j = 0; j < 4; ++j) { v[j] = __builtin_nontemporal_load(xr + 64 * j); s += (v[j].x * v[j].x + v[j].y * v[j].y) + (v[j].z * v[j].z + v[j].w * v[j].w); }
    const float rstd = 1.0f / sqrtf(wave_sum(s) * (1.f / DM) + RMS_EPS);
    u32x2* o8 = (u32x2*)dst + lane;
#pragma unroll
    for (int j = 0; j < 4; ++j) { const f32x4 gg = g4[64 * j]; u32x2 w; w.x = pk2(v[j].x * rstd * gg.x, v[j].y * rstd * gg.y); w.y = pk2(v[j].z * rstd * gg.z, v[j].w * rstd * gg.w); o8[64 * j] = w; }
}
__device__ __forceinline__ void p0_prologue(const Params& p, LAS unsigned char* lds, int tid, int lane, int wave) {
    bf16_t* W1T = (bf16_t*)(p.ws + WS_W1T); bf16_t* W2T = (bf16_t*)(p.ws + WS_W2T);
    bf16_t* HM = (bf16_t*)(p.ws + WS_HM); bf16_t* HB = (bf16_t*)((unsigned char*)p.out + OUT_HB);
    const int G = gridDim.x;
    LAS float* scr = (LAS float*)(lds + wave * 16384);
    const int gw = blockIdx.x * 8 + wave, NGW = G * 8;
    constexpr int IF = 2048, I1 = 16 * 160, I2 = 32 * 32;
    const int nrows = MR + NMETA, half = ((nrows / NGW) / 2) * NGW;
    if (wave & 1) for (int row = gw; row < half; row += NGW) p0_norm_row(p, HB, HM, row, lane);
    for (int it = gw; it < IF; it += NGW) p0_fold_item(p, W1T, scr, it, lane);
    for (int it = gw; it < I1 + I2; it += NGW) {
        if (it < I1) { const int kb = it / 160, nb = it % 160; const int nn = 1024 + nb * 32; p0_transpose_item(p.w_in, NPROJ, 1024, W1T, scr, kb * 64, nn, lane, (nn >= 2048 && nn < 3072) ? 0.125f * 1.4426950408889634f : 1.0f); }
        else { const int r = it - I1; const int kb = r / 32, nb = r % 32; p0_transpose_item(p.w_out, 1024, 2048, W2T, scr, kb * 64, nb * 32, lane, 1.0f); }
    }
    if (!(wave & 1)) for (int row = gw; row < half; row += NGW) p0_norm_row(p, HB, HM, row, lane);
    for (int row = half + gw; row < nrows; row += NGW) p0_norm_row(p, HB, HM, row, lane);
}

__device__ __forceinline__ void meta_proj(const Params& p, int lane, int wave) {
    const bf16_t* W1T = (const bf16_t*)(p.ws + WS_W1T); const bf16_t* HM = (const bf16_t*)(p.ws + WS_HM); float* PM = (float*)(p.ws + WS_PROJM);
    const int gw = blockIdx.x * 8 + wave, NGW = gridDim.x * 8, fr = lane & 15, fq = lane >> 4;
    for (int j = gw; j < NPROJ / 16; j += NGW) {
        const int n0 = 16 * j; f32x4 acc = {0.f, 0.f, 0.f, 0.f};
        const bf16_t* wa = W1T + (size_t)(n0 + fr) * 1024 + 8 * fq; const bf16_t* hb = HM + (size_t)fr * 1024 + 8 * fq;
#pragma unroll 4
        for (int kk = 0; kk < 32; ++kk) { const bf16x8 a = *(const bf16x8*)(wa + 32 * kk), b = *(const bf16x8*)(hb + 32 * kk);
            acc = __builtin_amdgcn_mfma_f32_16x16x32_bf16(a, b, acc, 0, 0, 0); }
        *(f32x4*)(PM + (size_t)fr * NPROJ + n0 + 4 * fq) = acc;
        if (n0 < 1024) { u32x2 w; w.x = pk2(acc[0], acc[1]); w.y = pk2(acc[2], acc[3]); *(u32x2*)((bf16_t*)(p.ws + WS_UM) + (size_t)fr * 1024 + n0 + 4 * fq) = w; }
    }
}

constexpr int AT_NS = 9;
constexpr int AT_KR = 0, AT_VR = AT_NS * 8192, AT_KM = 2 * AT_NS * 8192, AT_VM = AT_KM + 2048, AT_RPB = AT_VM + 2048, AT_END = AT_RPB + 2048;
static_assert(AT_END <= LDS_BYTES, "attention LDS map");
constexpr float LOG2E = 1.4426950408889634f;

__device__ __forceinline__ void attn_load_row(const bf16_t* P5, int seqbase, int R, int h, int tid, u32x4& kv, u32x4& vv) {
    const int col = tid >> 3, ch = tid & 7;
    const bf16_t* src = P5 + (size_t)(seqbase + R * 64 + col) * LDP5 + h * 64 + ch * 8;
    kv = __builtin_nontemporal_load((const u32x4*)(src + 2048)); vv = __builtin_nontemporal_load((const u32x4*)(src + 3072));
}
__device__ __forceinline__ void attn_write_row(LAS unsigned char* lds, int R, int tid, const u32x4 kv, const u32x4 vv) {
    const int col = tid >> 3, ch = tid & 7, slot = R % AT_NS;
    *(LAS u32x4*)(lds + AT_KR + slot * 8192 + col * 128 + ((ch ^ ((col >> 1) & 7)) << 4)) = kv;
#pragma unroll
    for (int i = 0; i < 8; ++i) { const int d = 8 * ch + i; const int sw = ((d >> 1) ^ (d >> 3)) & 7; const int pg = (col >> 2) ^ (sw << 1);
        const unsigned w = vv[i >> 1]; const unsigned short val = (unsigned short)((i & 1) ? (w >> 16) : (w & 0xffffu));
        *(LAS unsigned short*)(lds + AT_VR + slot * 8192 + d * 128 + pg * 8 + (col & 3) * 2) = val; }
}

__device__ __forceinline__ void attn_phase(const Params& p, LAS unsigned char* lds, int tid, int lane, int wave, bf16_t* OB, int ldo) {
    const bf16_t* P5 = (const bf16_t*)(p.ws + WS_P5); const float* PM = (const float*)(p.ws + WS_PROJM);
    const int fr = lane & 15, fq = lane >> 4, qg = wave & 3, rsel = wave >> 2;
    const int c0 = (qg == 0) ? 0 : (qg == 1 ? 8 : (qg == 2 ? 24 : 32));
    const int cq = 16 * qg + fr;
    const int cst = min(max(cq - 8, 0), 48);
    LAS float* rpbL = (LAS float*)(lds + AT_RPB);
    int kad[2][2], vad[4][2];
#pragma unroll
    for (int blk = 0; blk < 2; ++blk) { const int col = c0 + 16 * blk + fr, sw = (col >> 1) & 7; kad[blk][0] = col * 128 + ((fq ^ sw) << 4); kad[blk][1] = col * 128 + (((4 + fq) ^ sw) << 4); }
#pragma unroll
    for (int db = 0; db < 4; ++db) { const int d = 16 * db + fr, sw = ((d >> 1) ^ (d >> 3)) & 7, g0 = (c0 >> 2) + fq; vad[db][0] = d * 128 + ((g0 ^ (sw << 1)) << 3); vad[db][1] = d * 128 + (((g0 + 4) ^ (sw << 1)) << 3); }
    const int kmad0 = fr * 128 + ((fq ^ ((fr >> 1) & 7)) << 4), kmad1 = fr * 128 + (((4 + fq) ^ ((fr >> 1) & 7)) << 4);
    for (int run = blockIdx.x; run < 768; run += gridDim.x) {
        int s, h, rb, rows;
        if (run < 256) { s = run >> 5; const int rem = run & 31; h = rem >> 1; rb = rem & 1; rows = 32; }
        else { const int idx = run - 256; s = 8 + (idx >> 7); const int rem = idx & 127; h = rem >> 3; rb = rem & 7; rows = 128; }
        const int seqbase = s < 8 ? s * 2048 : MP + (s - 8) * 8192;
        const int r0 = rb * 16;
        __syncthreads();
        const int rs0 = min(max(r0 - 4, 0), rows - 8);
        {
            u32x4 kv[AT_NS], vv[AT_NS];
#pragma unroll
            for (int j = 0; j < AT_NS; ++j) attn_load_row(P5, seqbase, rs0 + j, h, tid, kv[j], vv[j]);
            for (int i = tid; i < 465; i += 512) rpbL[i] = p.rpb[h * 465 + i] * LOG2E;
            if (tid < 16) rpbL[480 + tid] = p.meta_bias[h * 16 + tid] * LOG2E;
            for (int i = tid; i < 1024; i += 512) { const int m = i >> 6, d = i & 63;
                const float kf = PM[(size_t)m * NPROJ + 3072 + h * 64 + d], vf = PM[(size_t)m * NPROJ + 4096 + h * 64 + d];
                *(LAS unsigned short*)(lds + AT_KM + m * 128 + (((d >> 3) ^ ((m >> 1) & 7)) << 4) + (d & 7) * 2) = (unsigned short)f2bf(kf);
                *(LAS unsigned short*)(lds + AT_VM + d * 32 + m * 2) = (unsigned short)f2bf(vf); }
#pragma unroll
            for (int j = 0; j < AT_NS; ++j) attn_write_row(lds, rs0 + j, tid, kv[j], vv[j]);
        }
        int res_hi = rs0 + AT_NS;
        u32x2 binit[8][2]; int cur_delta = -1;
        f32x4 mbinit = {0.f, 0.f, 0.f, 0.f};
        size_t tok = (size_t)(seqbase + (r0 + rsel) * 64 + cq);
        bf16x8 q0 = *(const bf16x8*)(P5 + tok * LDP5 + 1024 + h * 64 + 8 * fq), q1 = *(const bf16x8*)(P5 + tok * LDP5 + 1024 + h * 64 + 32 + 8 * fq);
        u32x2 gt[4];
#pragma unroll
        for (int db = 0; db < 4; ++db) gt[db] = *(const u32x2*)(P5 + tok * LDP5 + 4096 + h * 64 + 16 * db + 4 * fq);
        for (int ra = r0; ra < r0 + 16; ra += 2) {
            const int r = ra + rsel;
            const int rs = min(max(r - 4, 0), rows - 8);
            const bool more = (ra + 2 < r0 + 16);
            int nnewN = 0, needN = res_hi; const size_t tokN = tok + 128;
            u32x4 kaN = {0u, 0u, 0u, 0u}, vaN = kaN, kbN = kaN, vbN = kaN; bf16x8 q0N = q0, q1N = q1; u32x2 gtN[4] = {gt[0], gt[1], gt[2], gt[3]};
            if (more) {
                needN = min(max(ra + 3 - 4, 0), rows - 8) + 8; nnewN = needN - res_hi;
                if (nnewN >= 1) attn_load_row(P5, seqbase, res_hi, h, tid, kaN, vaN);
                if (nnewN >= 2) attn_load_row(P5, seqbase, res_hi + 1, h, tid, kbN, vbN);
                q0N = *(const bf16x8*)(P5 + tokN * LDP5 + 1024 + h * 64 + 8 * fq); q1N = *(const bf16x8*)(P5 + tokN * LDP5 + 1024 + h * 64 + 32 + 8 * fq);
#pragma unroll
                for (int db = 0; db < 4; ++db) gtN[db] = *(const u32x2*)(P5 + tokN * LDP5 + 4096 + h * 64 + 16 * db + 4 * fq);
            }
            __syncthreads();
            if (r - rs != cur_delta) {
                cur_delta = r - rs;
#pragma unroll
                for (int k8 = 0; k8 < 8; ++k8) { const int roff = (k8 + 7 - cur_delta) * 31;
#pragma unroll
                    for (int blk = 0; blk < 2; ++blk) { float bb[4];
#pragma unroll
                        for (int i = 0; i < 4; ++i) { const int kc = c0 + 16 * blk + 4 * fq + i; const bool ok = (unsigned)(kc - cst) < 16u; const int co = ok ? (kc - cq + 15) : 0;
                            const float b = rpbL[roff + co]; bb[i] = ok ? b : -30000.0f; }
                        binit[k8][blk].x = pg8::cvt_pk_bf16(bb[0], bb[1]); binit[k8][blk].y = pg8::cvt_pk_bf16(bb[2], bb[3]); } }
#pragma unroll
                for (int i = 0; i < 4; ++i) mbinit[i] = rpbL[480 + 4 * fq + i];
            }
            const int slot0 = rs % AT_NS;
            int sbase[8];
#pragma unroll
            for (int k8 = 0; k8 < 8; ++k8) { int slot = slot0 + k8; slot = slot >= AT_NS ? slot - AT_NS : slot; sbase[k8] = slot * 8192; }
            float mrun = -INFINITY;
            f32x4 O[4]; f32x4 L4 = {0.f, 0.f, 0.f, 0.f};
            const bf16x8 ones = {(short)0x3F80, (short)0x3F80, (short)0x3F80, (short)0x3F80, (short)0x3F80, (short)0x3F80, (short)0x3F80, (short)0x3F80};
#pragma unroll
            for (int db = 0; db < 4; ++db) O[db] = (f32x4){0.f, 0.f, 0.f, 0.f};
#pragma unroll
            for (int hf = 0; hf < 2; ++hf) {
                f32x4 S[4][2]; f32x4 Sm = mbinit;
                {
                    bf16x8 kf[2][2][2];
#define AT_RDK(buf, k8_) do { const LAS unsigned char* kbp = lds + AT_KR + sbase[k8_]; \
                    _Pragma("unroll") for (int blk = 0; blk < 2; ++blk) { kf[buf][blk][0] = *(const LAS bf16x8*)(kbp + kad[blk][0]); kf[buf][blk][1] = *(const LAS bf16x8*)(kbp + kad[blk][1]); } } while (0)
                    AT_RDK(0, 4 * hf);
#pragma unroll
                    for (int k4 = 0; k4 < 4; ++k4) {
                        if (k4 < 3) AT_RDK((k4 + 1) & 1, 4 * hf + k4 + 1);
                        __builtin_amdgcn_sched_barrier(0);
                        __builtin_amdgcn_s_setprio(1);
#pragma unroll
                        for (int blk = 0; blk < 2; ++blk) { const u32x2 bp = binit[4 * hf + k4][blk]; f32x4 a = {bflo(bp.x), bfhi(bp.x), bflo(bp.y), bfhi(bp.y)};
                            a = __builtin_amdgcn_mfma_f32_16x16x32_bf16(kf[k4 & 1][blk][0], q0, a, 0, 0, 0);
                            a = __builtin_amdgcn_mfma_f32_16x16x32_bf16(kf[k4 & 1][blk][1], q1, a, 0, 0, 0);
                            S[k4][blk] = a; }
                        __builtin_amdgcn_s_setprio(0);
                        __builtin_amdgcn_sched_barrier(0);
                    }
#undef AT_RDK
                }
                float mloc = -INFINITY;
                if (hf == 0) {
                    const bf16x8 k0 = *(const LAS bf16x8*)(lds + AT_KM + kmad0), k1 = *(const LAS bf16x8*)(lds + AT_KM + kmad1);
                    Sm = __builtin_amdgcn_mfma_f32_16x16x32_bf16(k0, q0, Sm, 0, 0, 0);
                    Sm = __builtin_amdgcn_mfma_f32_16x16x32_bf16(k1, q1, Sm, 0, 0, 0);
                    mloc = fmaxf(fmaxf(Sm[0], Sm[1]), fmaxf(Sm[2], Sm[3]));
                }
#pragma unroll
                for (int k4 = 0; k4 < 4; ++k4)
#pragma unroll
                    for (int blk = 0; blk < 2; ++blk) { const f32x4 a = S[k4][blk]; mloc = __builtin_fmaxf(__builtin_fmaxf(mloc, a[0]), a[1]); mloc = __builtin_fmaxf(__builtin_fmaxf(mloc, a[2]), a[3]); }
                mloc = xred_max(mloc);
                const float mx = fmaxf(mrun, mloc);
                if (hf == 1) { const float alpha = __builtin_amdgcn_exp2f(mrun - mx); L4 = L4 * alpha;
#pragma unroll
                    for (int db = 0; db < 4; ++db) O[db] = O[db] * alpha; }
                mrun = mx;
                {
                    u32x2 vf[2][4][2];
#define AT_RDV(buf, k8_) do { const LAS unsigned char* vbp = lds + AT_VR + sbase[k8_]; _Pragma("unroll") for (int db = 0; db < 4; ++db) { \
                    vf[buf][db][0] = *(const LAS u32x2*)(vbp + vad[db][0]); vf[buf][db][1] = *(const LAS u32x2*)(vbp + vad[db][1]); } } while (0)
                    AT_RDV(0, 4 * hf);
#pragma unroll
                    for (int k4 = 0; k4 < 4; ++k4) {
                        if (k4 < 3) AT_RDV((k4 + 1) & 1, 4 * hf + k4 + 1);
                        __builtin_amdgcn_sched_barrier(0);
                        float pv[8];
#pragma unroll
                        for (int blk = 0; blk < 2; ++blk)
#pragma unroll
                            for (int i = 0; i < 4; i += 2) { const f32x2 d = (f32x2){S[k4][blk][i], S[k4][blk][i + 1]} - (f32x2){mx, mx};
                                pv[blk * 4 + i] = __builtin_amdgcn_exp2f(d.x); pv[blk * 4 + i + 1] = __builtin_amdgcn_exp2f(d.y); }
                        u32x4 pw; pw.x = pg8::cvt_pk_bf16(pv[0], pv[1]); pw.y = pg8::cvt_pk_bf16(pv[2], pv[3]); pw.z = pg8::cvt_pk_bf16(pv[4], pv[5]); pw.w = pg8::cvt_pk_bf16(pv[6], pv[7]);
                        const bf16x8 pf = __builtin_bit_cast(bf16x8, pw);
                        __builtin_amdgcn_s_setprio(1);
#pragma unroll
                        for (int db = 0; db < 4; ++db) { u32x4 vw; vw.x = vf[k4 & 1][db][0].x; vw.y = vf[k4 & 1][db][0].y; vw.z = vf[k4 & 1][db][1].x; vw.w = vf[k4 & 1][db][1].y;
                            O[db] = __builtin_amdgcn_mfma_f32_16x16x32_bf16(__builtin_bit_cast(bf16x8, vw), pf, O[db], 0, 0, 0); }
                        L4 = __builtin_amdgcn_mfma_f32_16x16x32_bf16(ones, pf, L4, 0, 0, 0);
                        __builtin_amdgcn_s_setprio(0);
                        __builtin_amdgcn_sched_barrier(0);
                    }
#undef AT_RDV
                }
                if (hf == 0) {
                    float pv[4];
#pragma unroll
                    for (int i = 0; i < 4; ++i) pv[i] = __builtin_amdgcn_exp2f(Sm[i] - mx);
                    u32x4 pw; pw.x = pg8::cvt_pk_bf16(pv[0], pv[1]); pw.y = pg8::cvt_pk_bf16(pv[2], pv[3]); pw.z = 0u; pw.w = 0u;
                    const bf16x8 pf = __builtin_bit_cast(bf16x8, pw);
#pragma unroll
                    for (int db = 0; db < 4; ++db) { const int d = 16 * db + fr; const u32x2 x0 = *(const LAS u32x2*)(lds + AT_VM + d * 32 + fq * 8);
                        u32x4 vw; vw.x = x0.x; vw.y = x0.y; vw.z = 0u; vw.w = 0u;
                        O[db] = __builtin_amdgcn_mfma_f32_16x16x32_bf16(__builtin_bit_cast(bf16x8, vw), pf, O[db], 0, 0, 0); }
                    L4 = __builtin_amdgcn_mfma_f32_16x16x32_bf16(ones, pf, L4, 0, 0, 0);
                }
            }
            const float lsum = L4[0];
            __syncthreads();
            {
                const float inv = __builtin_amdgcn_rcpf(lsum);
                u32x2 wv[4];
#pragma unroll
                for (int db = 0; db < 4; ++db) { float o[4];
                    const float g0 = bflo(gt[db].x), g1 = bfhi(gt[db].x), g2 = bflo(gt[db].y), g3 = bfhi(gt[db].y);
                    o[0] = O[db][0] * inv * g0 * __builtin_amdgcn_rcpf(1.f + __expf(-g0)); o[1] = O[db][1] * inv * g1 * __builtin_amdgcn_rcpf(1.f + __expf(-g1));
                    o[2] = O[db][2] * inv * g2 * __builtin_amdgcn_rcpf(1.f + __expf(-g2)); o[3] = O[db][3] * inv * g3 * __builtin_amdgcn_rcpf(1.f + __expf(-g3));
                    wv[db].x = pg8::cvt_pk_bf16(o[0], o[1]); wv[db].y = pg8::cvt_pk_bf16(o[2], o[3]); }
#pragma unroll
                for (int pq = 0; pq < 4; pq += 2) {
                    const auto rx = __builtin_amdgcn_permlane16_swap(wv[pq].x, wv[pq + 1].x, false, false);
                    const auto ry = __builtin_amdgcn_permlane16_swap(wv[pq].y, wv[pq + 1].y, false, false);
                    u32x4 v; v.x = rx[0]; v.y = ry[0]; v.z = rx[1]; v.w = ry[1];
                    const int col = (fq & 1) ? 16 * (pq + 1) + 4 * (fq - 1) : 16 * pq + 4 * fq;
                    *(u32x4*)(OB + tok * ldo + h * 64 + col) = v; }
            }
            if (nnewN >= 1) attn_write_row(lds, res_hi, tid, kaN, vaN);
            if (nnewN >= 2) attn_write_row(lds, res_hi + 1, tid, kbN, vbN);
            if (nnewN > 0) res_hi = needN;
            q0 = q0N; q1 = q1N; tok = tokN;
#pragma unroll
            for (int db = 0; db < 4; ++db) gt[db] = gtN[db];
        }
    }
    __syncthreads();
}

template <int CH> struct PackT;
template <> struct PackT<8> { typedef u32x4 type; };
template <> struct PackT<4> { typedef u32x2 type; };
__device__ __forceinline__ void unpackv(const u32x4 w, float (&v)[8]) {
    v[0] = bflo(w.x); v[1] = bfhi(w.x); v[2] = bflo(w.y); v[3] = bfhi(w.y); v[4] = bflo(w.z); v[5] = bfhi(w.z); v[6] = bflo(w.w); v[7] = bfhi(w.w);
}
__device__ __forceinline__ void unpackv(const u32x2 w, float (&v)[4]) { v[0] = bflo(w.x); v[1] = bfhi(w.x); v[2] = bflo(w.y); v[3] = bfhi(w.y); }
__device__ __forceinline__ void packv(const float (&o)[8], u32x4& w) { w.x = pg8::cvt_pk_bf16(o[0], o[1]); w.y = pg8::cvt_pk_bf16(o[2], o[3]); w.z = pg8::cvt_pk_bf16(o[4], o[5]); w.w = pg8::cvt_pk_bf16(o[6], o[7]); }
__device__ __forceinline__ void packv(const float (&o)[4], u32x2& w) { w.x = pg8::cvt_pk_bf16(o[0], o[1]); w.y = pg8::cvt_pk_bf16(o[2], o[3]); }
template <int HALF, int TS, int CH>
__device__ __forceinline__ void pool_task(const bf16_t* U, const bf16_t* UM, const bf16_t* P5, const float* pool_scale, int seqbase, int T, int t0, int n0, bf16_t* OB, int ldo) {
    typedef typename PackT<CH>::type V;
    constexpr int NR = TS + 2 * HALF;
    asm volatile("" : "+v"(n0), "+v"(t0));
    V rows[NR];
    const bf16_t* base = U + ((long)(seqbase + t0) - HALF) * 1024 + n0;
    const bool first = (t0 == 0);
#pragma unroll
    for (int i = 0; i < NR; ++i) {
        const bf16_t* src = base + (long)i * 1024;
        if (i < HALF) src = first ? UM + (size_t)(16 - HALF + i) * 1024 + n0 : src;
        V w = *(const V*)src;
        if (i >= TS + HALF) { if (t0 - HALF + i >= T) w = V{}; }
        rows[i] = w; }
    float ps[CH];
#pragma unroll
    for (int c = 0; c < CH; c += 4) { const f32x4 a = *(const f32x4*)(pool_scale + n0 + c); ps[c] = a.x; ps[c + 1] = a.y; ps[c + 2] = a.z; ps[c + 3] = a.w; }
    float sum[CH];
#pragma unroll
    for (int i = 0; i < CH; ++i) sum[i] = 0.f;
#pragma unroll
    for (int i = 0; i < 2 * HALF; ++i) { float v[CH]; unpackv(rows[i], v);
#pragma unroll
        for (int c = 0; c < CH; ++c) sum[c] += v[c]; }
#pragma unroll
    for (int hb = 0; hb < TS / 8; ++hb) {
        V gts[8];
#pragma unroll
        for (int k = 0; k < 8; ++k) gts[k] = *(const V*)(P5 + (size_t)(seqbase + t0 + hb * 8 + k) * LDP5 + n0);
#pragma unroll
        for (int k8 = 0; k8 < 8; ++k8) { const int k = hb * 8 + k8; const int t = t0 + k;
            const int cnt = min(t + HALF, T) - (t - HALF); const float ic = __builtin_amdgcn_rcpf((float)cnt);
            float ctr[CH], add[CH], sub[CH], gv[CH]; unpackv(rows[k + HALF], ctr); unpackv(rows[k + 2 * HALF], add); unpackv(rows[k], sub); unpackv(gts[k8], gv);
            float o[CH];
#pragma unroll
            for (int c = 0; c < CH; c += 2) {
                const f32x2 gg = {gv[c], gv[c + 1]}, sm = {sum[c], sum[c + 1]}, ct = {ctr[c], ctr[c + 1]}, pp = {ps[c], ps[c + 1]};
                const f32x2 tt = gg * (-1.4426950408889634f); f32x2 den; den.x = __builtin_amdgcn_exp2f(tt.x); den.y = __builtin_amdgcn_exp2f(tt.y); den = den + 1.0f;
                f32x2 sg; sg.x = __builtin_amdgcn_rcpf(den.x); sg.y = __builtin_amdgcn_rcpf(den.y);
                const f32x2 r = (sm * ic - ct) * pp * (gg * sg);
                o[c] = r.x; o[c + 1] = r.y; sum[c] += add[c] - sub[c]; sum[c + 1] += add[c + 1] - sub[c + 1]; }
            V w; packv(o, w);
            *(V*)(OB + (size_t)(seqbase + t) * ldo + n0) = w;
            __builtin_amdgcn_sched_barrier(0); }
    }
}
__device__ __forceinline__ void pool_phase(const Params& p, int lane, int wave, bf16_t* OB, int ldo) {
    const bf16_t* U = (const bf16_t*)((const unsigned char*)p.out + OUT_U); const bf16_t* P5 = (const bf16_t*)(p.ws + WS_P5); const bf16_t* UM = (const bf16_t*)(p.ws + WS_UM);
    const int gw = blockIdx.x * 8 + wave, NGW = gridDim.x * 8;
    for (int task = gw; task < (MR / 32) * 4; task += NGW) {
        const int g = task & 3, st = task >> 2, tw = st * 32;
        int seqbase, T; if (tw < MP) { seqbase = tw & ~2047; T = 2048; } else { seqbase = MP + ((tw - MP) & ~8191); T = 8192; }
        const int t0 = tw - seqbase + (lane >> 5) * 16, n0 = g * 256 + (lane & 31) * 8;
        if (g == 0) pool_task<1, 16, 8>(U, UM, P5, p.pool_scale, seqbase, T, t0, n0, OB, ldo);
        else if (g == 1) pool_task<2, 16, 8>(U, UM, P5, p.pool_scale, seqbase, T, t0, n0, OB, ldo);
        else if (g == 2) { pool_task<4, 8, 8>(U, UM, P5, p.pool_scale, seqbase, T, t0, n0, OB, ldo); asm volatile("" ::: "memory"); pool_task<4, 8, 8>(U, UM, P5, p.pool_scale, seqbase, T, t0 + 8, n0, OB, ldo); }
        else { const int tu = tw - seqbase, n4 = 768 + lane * 4;
            pool_task<8, 16, 4>(U, UM, P5, p.pool_scale, seqbase, T, tu, n4, OB, ldo); asm volatile("" ::: "memory"); pool_task<8, 16, 4>(U, UM, P5, p.pool_scale, seqbase, T, tu + 16, n4, OB, ldo); }
    }
}

__device__ __forceinline__ void final_norm(const Params& p, int lane, int wave) {
    const float* ssq = (const float*)(p.ws + WS_SSQ); const f32x4* g4 = (const f32x4*)p.final_g + lane;
    const int gw = blockIdx.x * 8 + wave, NGW = gridDim.x * 8;
    f32x4 gg[4];
#pragma unroll
    for (int j = 0; j < 4; ++j) gg[j] = g4[64 * j];
    for (int row = gw; row < MR; row += NGW) {
        float s = lane < 16 ? ssq[(size_t)row * 16 + lane] : 0.f; s = wave_sum(s);
        const float rstd = 1.0f / sqrtf(s * (1.f / DM) + RMS_EPS);
        f32x4* o = (f32x4*)(p.out + (size_t)row * DM) + lane;
#pragma unroll
        for (int j = 0; j < 4; ++j) { const f32x4 v = o[64 * j]; o[64 * j] = v * rstd * gg[j]; }
    }
}

#define XB_TMO      128
#define XB_XCNT(j)  (256  + 64 * (j))
#define XB_XSUB(j)  (1280 + 64 * (j))
#define XB_XGEN(j)  (2304 + 64 * (j))
#define XB_TOP      3328
#define XB_TOPGEN   3392
#define XCD_BAR_WORDS 3456
#define XB_SPIN_CAP (1u << 18)

__device__ __forceinline__ unsigned xb_ld(unsigned* p)              { return __hip_atomic_load(p, __ATOMIC_RELAXED, __HIP_MEMORY_SCOPE_AGENT); }
__device__ __forceinline__ unsigned xb_add(unsigned* p, unsigned v) { return __hip_atomic_fetch_add(p, v, __ATOMIC_RELAXED, __HIP_MEMORY_SCOPE_AGENT); }
__device__ __forceinline__ unsigned xb_xcc_id() { return (unsigned)__builtin_amdgcn_s_getreg((3 << 11) | 20) & 0xFu; }
#define XB_SPIN(cond, bar) do { unsigned _sp = 0; while (cond) { __builtin_amdgcn_s_sleep(1); \
    if ((++_sp & 255u) == 0u) { if (xb_ld(&(bar)[XB_TMO])) break; if (_sp > XB_SPIN_CAP) { atomicAdd(&(bar)[XB_TMO], 1u); break; } } } } while (0)

struct XcdBarrier {
    unsigned* bar; unsigned x;
    volatile LAS unsigned* st;
};

__device__ __forceinline__ XcdBarrier xcd_barrier_post(unsigned* bar, volatile LAS unsigned* st) {
    XcdBarrier b; b.bar = bar; b.x = xb_xcc_id(); b.st = st;
    if (threadIdx.x == 0) (void)xb_add(&bar[XB_XCNT(b.x)], 1u);
    return b;
}
__device__ __forceinline__ void xcd_barrier_complete(unsigned* bar, unsigned x, unsigned& nloc, unsigned& nx) {
    const unsigned G = gridDim.x * gridDim.y * gridDim.z;
    unsigned sum, cnt, mine, sp = 0u;
    for (;;) {
        sum = 0u; cnt = 0u; mine = 0u;
#pragma unroll
        for (unsigned j = 0; j < 16; ++j) { const unsigned c = xb_ld(&bar[XB_XCNT(j)]); sum += c; cnt += (c > 0u) ? 1u : 0u; mine = (j == x) ? c : mine; }
        if (sum == G) break;
        __builtin_amdgcn_s_sleep(1);
        if ((++sp & 255u) == 0u) { if (xb_ld(&bar[XB_TMO])) break; if (sp > XB_SPIN_CAP) { atomicAdd(&bar[XB_TMO], 1u); break; } }
    }
    nloc = mine > 0u ? mine : 1u; nx = cnt > 0u ? cnt : 1u;
}

__device__ __forceinline__ void xcd_barrier(const XcdBarrier& b) {
    asm volatile("s_waitcnt vmcnt(0)" ::: "memory");
    __syncthreads();
    if (threadIdx.x == 0) {
        unsigned* bar = b.bar;
        __builtin_amdgcn_s_waitcnt(0);
        unsigned nloc = b.st[0], nx = b.st[1];
        if (nloc == 0u) { xcd_barrier_complete(bar, b.x, nloc, nx); b.st[0] = nloc; b.st[1] = nx; }
        const unsigned old = xb_add(&bar[XB_XSUB(b.x)], 1u);
        const unsigned gen = old / nloc;
        if (old + 1u == (gen + 1u) * nloc) {
            __builtin_amdgcn_fence(__ATOMIC_RELEASE, "agent");
            asm volatile("s_waitcnt vmcnt(0)" ::: "memory");
            const unsigned og = xb_add(&bar[XB_TOP], 1u);
            const unsigned tg = og / nx;
            if (og + 1u == (tg + 1u) * nx) xb_add(&bar[XB_TOPGEN], 1u);
            else XB_SPIN(xb_ld(&bar[XB_TOPGEN]) == tg, bar);
            __builtin_amdgcn_fence(__ATOMIC_ACQUIRE, "agent");
            xb_add(&bar[XB_XGEN(b.x)], 1u);
            asm volatile("s_waitcnt vmcnt(0)" ::: "memory");
        } else {
            XB_SPIN(xb_ld(&bar[XB_XGEN(b.x)]) == gen, bar);
            __builtin_amdgcn_fence(__ATOMIC_ACQUIRE, "agent");
            asm volatile("s_waitcnt vmcnt(0)" ::: "memory");
        }
    }
    __syncthreads();
}


__global__ void __launch_bounds__(512) fwd_megakernel(Params p) {
    extern __shared__ __attribute__((aligned(16))) unsigned char lds_raw[];
    LAS unsigned char* lds = (LAS unsigned char*)lds_raw;
    cg::grid_group grid = cg::this_grid();
    const int tid = threadIdx.x, lane = tid & 63, wave = __builtin_amdgcn_readfirstlane(tid >> 6);
    const int lo = p.ph_lo, hi = p.ph_hi;
#define IN(k) (lo <= (k) && (k) < hi)
    volatile LAS unsigned* bst = (volatile LAS unsigned*)(lds + LDS_BYTES - 64);
    if (tid < 2) bst[tid] = 0u;
    __syncthreads();
    XcdBarrier xbar; xbar.bar = (unsigned*)(p.ws + WS_BAR); xbar.x = 0; xbar.st = bst;
#define SEAM(k) do { if (IN(k) && IN((k) + 1)) { if ((k) == 0) grid.sync(); else xcd_barrier(xbar); } } while (0)
#if MK_N_LAUNCHES == 1
    if (blockIdx.x == 0) { unsigned* cw = (unsigned*)(p.ws + WS_CNT); for (int i = tid; i < (65536 + 16384) / 4; i += 512) cw[i] = 0u; }
#endif
#ifndef PROBE_DUP
#define PROBE_DUP 0
#endif
    if (IN(0)) { p0_prologue(p, lds, tid, lane, wave); if (PROBE_DUP == 5) p0_prologue(p, lds, tid, lane, wave); }
    SEAM(0);
    if (IN(0) && IN(1)) xbar = xcd_barrier_post((unsigned*)(p.ws + WS_BAR), bst);
    if (IN(1)) {
        meta_proj(p, lane, wave);
        pg8::Gemm g{(const bf16_t*)((const unsigned char*)p.out + OUT_HB), (const bf16_t*)(p.ws + WS_W1T), MR, NPROJ, 1024, 1024};
        pg8::StaticOrder S; S.init(MR, NPROJ, gridDim.x, blockIdx.x);
        pg8::EpiProj E{(bf16_t*)((unsigned char*)p.out + OUT_U), (bf16_t*)(p.ws + WS_P5)};
        pg8::gemm_phase<pg8::EpiProj, pg8::StaticOrder, true>(lds, g, S, E);
        if (PROBE_DUP == 1) pg8::gemm_phase<pg8::EpiProj, pg8::StaticOrder, true>(lds, g, S, E);
    }
    SEAM(1);
    if (IN(2)) {
        bf16_t* P5o = (bf16_t*)(p.ws + WS_P5); bf16_t* SCR = (bf16_t*)((unsigned char*)p.out + OUT_HB);
        if (PROBE_DUP == 2) attn_phase(p, lds, tid, lane, wave, SCR, 1024);
        if (PROBE_DUP == 3) pool_phase(p, lane, wave, SCR, 1024);
        if (blockIdx.x & 1) pool_phase(p, lane, wave, P5o, LDP5);
        attn_phase(p, lds, tid, lane, wave, P5o + 1024, LDP5);
        if (!(blockIdx.x & 1)) pool_phase(p, lane, wave, P5o, LDP5);
    }
    SEAM(2);
    if (IN(3)) {
        pg8::Gemm g{(const bf16_t*)(p.ws + WS_P5), (const bf16_t*)(p.ws + WS_W2T), MR, 1024, 2048, LDP5};
#if FUSE_NORM
        pg8::PanelOrder S; S.init(MR, 1024, gridDim.x, blockIdx.x);
        pg8::EpiOutN E{p.xp, p.xs, p.out, (float*)(p.ws + WS_SSQ), (unsigned*)(p.ws + WS_CNT), p.final_g, lds + 131072};
        pg8::gemm_phase<pg8::EpiOutN, pg8::PanelOrder, true>(lds, g, S, E);
#else
        pg8::StaticOrder S; S.init(MR, 1024, gridDim.x, blockIdx.x);
        pg8::EpiOut E{p.xp, p.xs, p.out, (float*)(p.ws + WS_SSQ)};
        pg8::gemm_phase<pg8::EpiOut, pg8::StaticOrder, true>(lds, g, S, E);
        if (PROBE_DUP == 4) pg8::gemm_phase<pg8::EpiOut, pg8::StaticOrder, true>(lds, g, S, E);
#endif
    }
#if !FUSE_NORM
    SEAM(3);
    if (IN(4)) { final_norm(p, lane, wave); }
#endif
#undef IN
#undef SEAM
}

extern "C" void kernel_launch(void* const* d_in, const int* in_sizes, int n_in, void* d_out, int out_size, void* d_ws, size_t ws_size, hipStream_t stream) {
    static int grid = 0;
    if (grid == 0) {
        if (n_in != 11 || out_size != MR * DM || ws_size < WS_END) { fprintf(stderr, "kernel_launch: unexpected shapes: n_in %d out %d ws %zu (need %zu)\n", n_in, out_size, ws_size, (size_t)WS_END); grid = -1; return; }
        int dev = 0, cus = 0, per_cu = 0;
        if (hipGetDevice(&dev) != hipSuccess || hipDeviceGetAttribute(&cus, hipDeviceAttributeMultiprocessorCount, dev) != hipSuccess) { grid = -1; return; }
        if (hipFuncSetAttribute((const void*)fwd_megakernel, hipFuncAttributeMaxDynamicSharedMemorySize, LDS_BYTES) != hipSuccess) { fprintf(stderr, "kernel_launch: hipFuncSetAttribute failed\n"); grid = -1; return; }
        if (hipOccupancyMaxActiveBlocksPerMultiprocessor(&per_cu, (const void*)fwd_megakernel, 512, LDS_BYTES) != hipSuccess || per_cu < 1) { fprintf(stderr, "kernel_launch: occupancy query failed (%d)\n", per_cu); grid = -1; return; }
        grid = cus * per_cu;
    }
    if (grid < 0) return;
    Params p{};
    p.xp = (const float*)d_in[0]; p.xs = (const float*)d_in[1]; p.meta = (const float*)d_in[2]; p.norm_g = (const float*)d_in[3]; p.w_in = (const float*)d_in[4];
    p.w_pool = (const float*)d_in[5]; p.pool_scale = (const float*)d_in[6]; p.rpb = (const float*)d_in[7]; p.meta_bias = (const float*)d_in[8]; p.w_out = (const float*)d_in[9];
    p.final_g = (const float*)d_in[10]; p.out = (float*)d_out; p.ws = (unsigned char*)d_ws;
#if FUSE_NORM && MK_N_LAUNCHES != 1
    if (hipMemsetAsync((char*)d_ws + WS_CNT, 0, 65536 + 16384, stream) != hipSuccess) { fprintf(stderr, "kernel_launch: memset failed\n"); return; }
#endif
#if MK_N_LAUNCHES == 1
    p.ph_lo = 0; p.ph_hi = 5;
    void* args[] = {&p};
    hipError_t e = hipLaunchCooperativeKernel((const void*)fwd_megakernel, dim3(grid), dim3(512), args, LDS_BYTES, stream);
    if (e != hipSuccess) fprintf(stderr, "kernel_launch: cooperative launch failed: %s (grid %d)\n", hipGetErrorString(e), grid);
#else
    for (int i = 0; i < 5; ++i) { p.ph_lo = i; p.ph_hi = i + 1; hipLaunchKernelGGL(fwd_megakernel, dim3(grid), dim3(512), LDS_BYTES, stream, p); }
#endif
}
```
